# Optimizing an MI355X kernel written in HIP

```python
import math
import jax, jax.numpy as jnp
from jax import lax
import numpy as np

D_MODEL = 1024
BATCH = 32
SEQ = 2048
DEPTH = 1

EPS = 1e-6
D_FF = 2816
ATTN_HEADS = 8
ATTN_QK_DIM = 64
ATTN_V_DIM = 2 * ATTN_QK_DIM
ATTN_WIDTH = ATTN_HEADS * ATTN_V_DIM
QK_COLS = ATTN_HEADS * 2 * ATTN_QK_DIM
ROT_DIM = ATTN_QK_DIM // 4
ROPE_THETA = 500000.0
Q_BLOCK = 128
SSD_HEADS = 16
SSD_HEAD_DIM = 64
SSD_INNER = SSD_HEADS * SSD_HEAD_DIM
SSD_GROUPS = 2
SSD_STATE = 128
SSD_CONV = 5
SSD_CHUNK = 128
CONV_CH = SSD_INNER + 2 * SSD_GROUPS * SSD_STATE
D_MIX = ATTN_WIDTH + SSD_INNER
IN_SPLITS = (
    QK_COLS,
    2 * QK_COLS,
    2 * QK_COLS + ATTN_WIDTH,
    2 * QK_COLS + ATTN_WIDTH + SSD_INNER,
    2 * QK_COLS + ATTN_WIDTH + SSD_INNER + CONV_CH,
)
D_IN = 2 * QK_COLS + ATTN_WIDTH + SSD_INNER + CONV_CH + 2 * SSD_HEADS

kernel_name = "hybrid_diffattn_ssd_macaron_block"


def rmsnorm(x, g):
    xf = x.astype(jnp.float32)
    y = xf * lax.rsqrt(jnp.mean(xf * xf, axis=-1, keepdims=True) + EPS)
    return (y * g.astype(jnp.float32)).astype(x.dtype)


def swiglu(x, w_gate, w_up, w_down):
    return (jax.nn.silu(x @ w_gate) * (x @ w_up)) @ w_down


def rotary_tables(seq, dtype):
    pos = jnp.arange(seq, dtype=jnp.float32)
    inv_freq = jnp.power(jnp.float32(ROPE_THETA),
                         -jnp.arange(0, ROT_DIM, 2, dtype=jnp.float32) / ROT_DIM)
    ang = pos[:, None] * inv_freq[None, :]
    return jnp.cos(ang).astype(dtype), jnp.sin(ang).astype(dtype)


def apply_partial_rotary(t, cos, sin):
    half = ROT_DIM // 2
    c = cos[:, None, None, :]
    s = sin[:, None, None, :]
    x1 = t[..., :half]
    x2 = t[..., half:ROT_DIM]
    return jnp.concatenate([x1 * c - x2 * s, x2 * c + x1 * s, t[..., ROT_DIM:]], axis=-1)


def diff_attention(q, k, v, lam):
    b, s = q.shape[0], q.shape[1]
    nb = s // Q_BLOCK
    qb = q.reshape(b, nb, Q_BLOCK, ATTN_HEADS, 2, ATTN_QK_DIM).swapaxes(0, 1)
    scale = ATTN_QK_DIM ** -0.5

    def block(qi):
        sc = jnp.einsum("bqhcd,bkhcd->bhcqk", qi, k).astype(jnp.float32) * scale
        p = jax.nn.softmax(sc, axis=-1)
        p_diff = p[:, :, 0] - lam * p[:, :, 1]
        return jnp.einsum("bhqk,bkhe->bqhe", p_diff.astype(v.dtype), v)

    out = lax.map(block, qb)
    return out.swapaxes(0, 1).reshape(b, s, ATTN_HEADS, ATTN_V_DIM)


def centred_depthwise_conv(u, w, bias):
    out = lax.conv_general_dilated(
        u, w[:, None, :], window_strides=(1,),
        padding=[(SSD_CONV // 2, SSD_CONV // 2)],
        dimension_numbers=("NWC", "WIO", "NWC"),
        feature_group_count=u.shape[-1])
    return out + bias


def ssd_chunked(xh, dt, a, bm, cm):
    b, l, h, p = xh.shape
    g, n = bm.shape[2], bm.shape[3]
    r = h // g
    c = l // SSD_CHUNK
    L = SSD_CHUNK
    xdt = (xh * dt[..., None]).reshape(b, c, L, g, r, p)
    da = (dt * a).reshape(b, c, L, h).transpose(0, 1, 3, 2)
    cs = jnp.cumsum(da, axis=-1)
    bc = bm.reshape(b, c, L, g, n)
    cc = cm.reshape(b, c, L, g, n)
    mask = jnp.tril(jnp.ones((L, L), dtype=bool))
    diff = cs[..., :, None] - cs[..., None, :]
    decay = jnp.where(mask, jnp.exp(jnp.where(mask, diff, 0.0)), 0.0)
    decay = decay.reshape(b, c, g, r, L, L)
    cb = jnp.einsum("bclgn,bcsgn->bcgls", cc, bc)
    y_diag = jnp.einsum("bcgrls,bcsgrp->bclgrp", cb[:, :, :, None] * decay, xdt)
    decay_states = jnp.exp(cs[..., -1:] - cs).reshape(b, c, g, r, L)
    states = jnp.einsum("bclgn,bcgrl,bclgrp->bcgrpn", bc, decay_states, xdt)
    chunk_decay = jnp.exp(cs[..., -1]).reshape(b, c, g, r)

    def step(prev, inp):
        s_c, d_c = inp
        return prev * d_c[..., None, None] + s_c, prev

    init = jnp.zeros((b, g, r, p, n), dtype=states.dtype)
    _, prev_states = lax.scan(step, init,
                              (states.swapaxes(0, 1), chunk_decay.swapaxes(0, 1)))
    prev_states = prev_states.swapaxes(0, 1)
    state_decay_out = jnp.exp(cs).reshape(b, c, g, r, L)
    y_off = jnp.einsum("bclgn,bcgrpn,bcgrl->bclgrp", cc, prev_states, state_decay_out)
    return (y_diag + y_off).reshape(b, l, h, p)


def hybrid_mixer(hn, layer_idx, p):
    b, s, _ = hn.shape
    u = hn @ p["w_in"]
    q, k, v, z, xbc, dt_raw = jnp.split(u, IN_SPLITS, axis=-1)

    q = q.reshape(b, s, ATTN_HEADS, 2, ATTN_QK_DIM)
    k = k.reshape(b, s, ATTN_HEADS, 2, ATTN_QK_DIM)
    v = v.reshape(b, s, ATTN_HEADS, ATTN_V_DIM)
    cos, sin = rotary_tables(s, q.dtype)
    q = apply_partial_rotary(q, cos, sin)
    k = apply_partial_rotary(k, cos, sin)
    lam_init = 0.8 - 0.6 * math.exp(-0.3 * layer_idx)
    f32 = jnp.float32
    lam = (jnp.exp(jnp.sum(p["lambda_q1"].astype(f32) * p["lambda_k1"].astype(f32)))
           - jnp.exp(jnp.sum(p["lambda_q2"].astype(f32) * p["lambda_k2"].astype(f32)))
           + lam_init)
    attn = diff_attention(q, k, v, lam)
    attn = rmsnorm(attn, p["attn_subln_g"]) * (1.0 - lam_init)
    attn = attn.reshape(b, s, ATTN_WIDTH)

    xbc = jax.nn.silu(centred_depthwise_conv(xbc, p["conv_w"], p["conv_b"]))
    xs, bm, cm = jnp.split(xbc, (SSD_INNER, SSD_INNER + SSD_GROUPS * SSD_STATE), axis=-1)
    xs = xs.reshape(b, s, SSD_HEADS, SSD_HEAD_DIM)
    bm = bm.reshape(b, s, SSD_GROUPS, SSD_STATE)
    cm = cm.reshape(b, s, SSD_GROUPS, SSD_STATE)
    dt_f, dt_b = jnp.split(dt_raw.astype(f32), 2, axis=-1)
    dt_f = jax.nn.softplus(dt_f + p["dt_bias_fwd"].astype(f32))
    dt_b = jax.nn.softplus(dt_b + p["dt_bias_bwd"].astype(f32))
    a_f = -jnp.exp(p["a_log_fwd"].astype(f32))
    a_b = -jnp.exp(p["a_log_bwd"].astype(f32))
    y_f = ssd_chunked(xs, dt_f, a_f, bm, cm)
    rev = lambda t: jnp.flip(t, axis=1)
    y_b = rev(ssd_chunked(rev(xs), rev(dt_b), a_b, rev(bm), rev(cm)))
    y = y_f + y_b + xs * p["d_skip"][:, None]
    y = y.reshape(b, s, SSD_INNER).astype(hn.dtype)
    y = rmsnorm(y * jax.nn.silu(z), p["ssd_norm_g"])

    mixed = jnp.concatenate([attn, y], axis=-1)
    return mixed @ p["w_out"]


def hybrid_layer(h, layer_idx, p):
    f = swiglu(rmsnorm(h, p["ffn1_pre_g"]), p["ffn1_w_gate"], p["ffn1_w_up"], p["ffn1_w_down"])
    h = h + 0.5 * rmsnorm(f, p["ffn1_post_g"])
    m = hybrid_mixer(rmsnorm(h, p["mix_pre_g"]), layer_idx, p)
    h = h + rmsnorm(m, p["mix_post_g"])
    f = swiglu(rmsnorm(h, p["ffn2_pre_g"]), p["ffn2_w_gate"], p["ffn2_w_up"], p["ffn2_w_down"])
    h = h + 0.5 * rmsnorm(f, p["ffn2_post_g"])
    return rmsnorm(h, p["final_g"])


def setup_inputs(seed: int = 0) -> dict:
    key = jax.random.key(seed)
    ks = iter(jax.random.split(key, 40))
    f32 = jnp.float32

    def w(shape, fan_in):
        return jax.random.normal(next(ks), shape, f32) * (fan_in ** -0.5)

    def gain(shape):
        return 1.0 + 0.02 * jax.random.normal(next(ks), shape, f32)

    def small(shape, scale):
        return scale * jax.random.normal(next(ks), shape, f32)

    def a_log():
        return jnp.log(jax.random.uniform(next(ks), (DEPTH, SSD_HEADS), f32, 1.0, 16.0))

    def dt_bias():
        dt = jnp.exp(jax.random.uniform(next(ks), (DEPTH, SSD_HEADS), f32,
                                        math.log(1e-3), math.log(1e-1)))
        return dt + jnp.log(-jnp.expm1(-dt))

    Dp = DEPTH
    x = jax.random.normal(next(ks), (BATCH, SEQ, D_MODEL), f32)
    return {
        "x": x,
        "ffn1_pre_g": gain((Dp, D_MODEL)),
        "ffn1_w_gate": w((Dp, D_MODEL, D_FF), D_MODEL),
        "ffn1_w_up": w((Dp, D_MODEL, D_FF), D_MODEL),
        "ffn1_w_down": w((Dp, D_FF, D_MODEL), D_FF),
        "ffn1_post_g": gain((Dp, D_MODEL)),
        "mix_pre_g": gain((Dp, D_MODEL)),
        "w_in": w((Dp, D_MODEL, D_IN), D_MODEL),
        "lambda_q1": small((Dp, ATTN_QK_DIM), 0.1),
        "lambda_k1": small((Dp, ATTN_QK_DIM), 0.1),
        "lambda_q2": small((Dp, ATTN_QK_DIM), 0.1),
        "lambda_k2": small((Dp, ATTN_QK_DIM), 0.1),
        "attn_subln_g": gain((Dp, ATTN_V_DIM)),
        "conv_w": w((Dp, SSD_CONV, CONV_CH), SSD_CONV),
        "conv_b": small((Dp, CONV_CH), 0.02),
        "a_log_fwd": a_log(),
        "a_log_bwd": a_log(),
        "dt_bias_fwd": dt_bias(),
        "dt_bias_bwd": dt_bias(),
        "d_skip": gain((Dp, SSD_HEADS)),
        "ssd_norm_g": gain((Dp, SSD_INNER)),
        "w_out": w((Dp, D_MIX, D_MODEL), D_MIX),
        "mix_post_g": gain((Dp, D_MODEL)),
        "ffn2_pre_g": gain((Dp, D_MODEL)),
        "ffn2_w_gate": w((Dp, D_MODEL, D_FF), D_MODEL),
        "ffn2_w_up": w((Dp, D_MODEL, D_FF), D_MODEL),
        "ffn2_w_down": w((Dp, D_FF, D_MODEL), D_FF),
        "ffn2_post_g": gain((Dp, D_MODEL)),
        "final_g": gain((Dp, D_MODEL)),
    }


def reference(x, ffn1_pre_g, ffn1_w_gate, ffn1_w_up, ffn1_w_down, ffn1_post_g,
              mix_pre_g, w_in, lambda_q1, lambda_k1, lambda_q2, lambda_k2,
              attn_subln_g, conv_w, conv_b, a_log_fwd, a_log_bwd, dt_bias_fwd,
              dt_bias_bwd, d_skip, ssd_norm_g, w_out, mix_post_g, ffn2_pre_g,
              ffn2_w_gate, ffn2_w_up, ffn2_w_down, ffn2_post_g, final_g):
    h = x
    for i in range(DEPTH):
        p = {
            "ffn1_pre_g": ffn1_pre_g[i], "ffn1_w_gate": ffn1_w_gate[i],
            "ffn1_w_up": ffn1_w_up[i], "ffn1_w_down": ffn1_w_down[i],
            "ffn1_post_g": ffn1_post_g[i], "mix_pre_g": mix_pre_g[i],
            "w_in": w_in[i], "lambda_q1": lambda_q1[i], "lambda_k1": lambda_k1[i],
            "lambda_q2": lambda_q2[i], "lambda_k2": lambda_k2[i],
            "attn_subln_g": attn_subln_g[i], "conv_w": conv_w[i], "conv_b": conv_b[i],
            "a_log_fwd": a_log_fwd[i], "a_log_bwd": a_log_bwd[i],
            "dt_bias_fwd": dt_bias_fwd[i], "dt_bias_bwd": dt_bias_bwd[i],
            "d_skip": d_skip[i], "ssd_norm_g": ssd_norm_g[i], "w_out": w_out[i],
            "mix_post_g": mix_post_g[i], "ffn2_pre_g": ffn2_pre_g[i],
            "ffn2_w_gate": ffn2_w_gate[i], "ffn2_w_up": ffn2_w_up[i],
            "ffn2_w_down": ffn2_w_down[i], "ffn2_post_g": ffn2_post_g[i],
            "final_g": final_g[i],
        }
        h = hybrid_layer(h, i, p)
    return h
```

```cpp
#include <hip/hip_runtime.h>
#include <hip/hip_cooperative_groups.h>
#include <cstdio>
#include <cstdint>
namespace cg = cooperative_groups;

#ifndef MK_SPLIT
#define MK_SPLIT 0
#endif

#define LAS __attribute__((address_space(3)))
typedef unsigned short bf16_t;
typedef short bf16x8 __attribute__((ext_vector_type(8)));
typedef short s16x4 __attribute__((ext_vector_type(4)));
typedef float f32x4 __attribute__((ext_vector_type(4)));
typedef float f32x16 __attribute__((ext_vector_type(16)));
typedef unsigned u32x4 __attribute__((ext_vector_type(4)));
typedef unsigned u32x2 __attribute__((ext_vector_type(2)));

constexpr int NB = 32, SEQ = 2048, DM = 1024, FF = 2816, T = NB * SEQ;
constexpr int ULD = 5632;
constexpr int NIN_P = 5888;
constexpr float EPS = 1e-6f;
constexpr int NTHREADS = 512, NWAVES = 8;

constexpr size_t MiB = 1u << 20;
constexpr size_t WS_LAM = 0, WS_ROT = 4096, WS_BAR = 512 * 1024, WS_BAR_BYTES = 16384, WS_DTT = 1 * MiB;
constexpr size_t WS_W1 = 10 * MiB, WS_WD1 = 21 * MiB, WS_WIN = 27 * MiB, WS_WOUT = 39 * MiB, WS_W2 = 43 * MiB, WS_WD2 = 54 * MiB;
constexpr size_t WS_XN = 64 * MiB, WS_F = 192 * MiB, WS_BIG = 320 * MiB, WS_XN3 = 672 * MiB, WS_NEED = 1024 * MiB;
constexpr size_t DO_XT = 0, DO_BM = 128 * MiB, DO_BMT = 160 * MiB, DO_CM = 192 * MiB;

constexpr int LDS_BYTES = 160 * 1024;

__device__ __forceinline__ unsigned cvt_pk_bf16(float lo, float hi) { unsigned r; asm volatile("v_cvt_pk_bf16_f32 %0, %1, %2" : "=v"(r) : "v"(lo), "v"(hi)); return r; }
typedef float f32x2_t __attribute__((ext_vector_type(2)));
typedef __bf16 bf16x2_t __attribute__((ext_vector_type(2)));
__device__ __forceinline__ unsigned cvt_pk_bf16_c(float lo, float hi) { const f32x2_t v = {lo, hi}; const bf16x2_t b = __builtin_convertvector(v, bf16x2_t); return __builtin_bit_cast(unsigned, b); }
__device__ __forceinline__ float bf_lo(unsigned w) { return __uint_as_float(w << 16); }
__device__ __forceinline__ float bf_hi(unsigned w) { return __uint_as_float(w & 0xffff0000u); }
__device__ __forceinline__ float bf1(bf16_t h) { return __uint_as_float(((unsigned)h) << 16); }
__device__ __forceinline__ float wave_sum(float v) {
#pragma unroll
    for (int o = 1; o < 64; o <<= 1) v += __shfl_xor(v, o);
    return v;
}
__device__ __forceinline__ float silu_f(float g) { return g * __builtin_amdgcn_rcpf(1.0f + __builtin_amdgcn_exp2f(-1.4426950408889634f * g)); }

namespace pg8 {
constexpr int BM = 256, BK = 64, HALF = 128, HTB = HALF * BK * 2, STAGE_BYTES = 8 * HTB, NXCD = 8, WGM = 8;
__host__ __device__ __forceinline__ int lds_byte(int r, int c) { const int st = (r >> 4) * 2 + (c >> 5), rr = r & 15, cc = c & 31, ob = rr * 64 + cc * 2; return st * 1024 + (ob ^ (((ob >> 9) & 1) << 5)); }
__host__ __device__ __forceinline__ void stage_rc(int b, int& R, int& C) { const int st = b / 1024, sb = b % 1024, swz = sb ^ (((sb >> 9) & 1) << 5); R = (st >> 1) * 16 + swz / 64; C = (st & 1) * 32 + (swz % 64) / 2; }
__host__ __device__ __forceinline__ int perm32(int rho) { const int n = rho >> 4, i = rho & 15; return 8 * (i >> 2) + 4 * n + (i & 3); }
struct Unit { int pm, pn; };
struct Gemm { const bf16_t* A; const bf16_t* Bt; int M, N, K, lda; };
struct StaticOrder {
    int nM, nN, nwg, G, c;
    __host__ __device__ void init(int M, int N, int G_, int c_) { nM = M / BM; nN = N / BM; nwg = nM * nN; G = G_; c = c_; }
    __host__ __device__ bool next(int i, Unit& u) const {
        const long L = (long)i * G + c; if (L >= nwg) return false;
        int wgid = (int)L; { const int q = nwg / NXCD, r = nwg % NXCD, xcd = wgid % NXCD, off = wgid / NXCD; wgid = (xcd < r ? xcd * (q + 1) : r * (q + 1) + (xcd - r) * q) + off; }
        const int nig = WGM * nN, gid = wgid / nig, fm = gid * WGM, gsz = (nM - fm) < WGM ? (nM - fm) : WGM;
        u.pm = fm + ((wgid % nig) % gsz); u.pn = (wgid % nig) / gsz; return true;
    }
};
template <class Epi>
__device__ __forceinline__ void gemm_phase(LAS unsigned char* lds, const Gemm g, const StaticOrder& S, const Epi& E) {
    const int tid = threadIdx.x, wid = __builtin_amdgcn_readfirstlane(tid >> 6), lane = tid & 63, wr = wid >> 2, wc = wid & 3, fr = lane & 15, fq = lane >> 4;
    const int K = g.K, nt = K / BK, lda = g.lda;
    unsigned voffA[2], voffB[2];
#pragma unroll
    for (int i = 0; i < 2; ++i) { int R, C; stage_rc(tid * 16 + i * 8192, R, C); const int Rb = (R & ~31) + perm32(R & 31); voffA[i] = (unsigned)(R * lda + C) * 2u; voffB[i] = (unsigned)(Rb * K + C) * 2u; }
    const size_t kstep = (size_t)(BK * 2);
    const size_t hstepA = (size_t)HALF * lda * 2, hstepB = (size_t)HALF * K * 2;
    const size_t tstepA = 2 * hstepA, tstepB = 2 * hstepB;
    const unsigned ldsw = (unsigned)wid * 1024u;
    const int aoff = lds_byte(wr * 64 + fr, fq * 8), boff = lds_byte(wc * 32 + fr, fq * 8);
#define PG8_SA(b, h) (((b) * 2 + (h)) * HTB)
#define PG8_SB(b, h) ((4 + (b) * 2 + (h)) * HTB)
#define PG8_STAGE(bufoff, gbase, voff) do { _Pragma("unroll") for (int _i = 0; _i < 2; ++_i) \
        __builtin_amdgcn_global_load_lds((const unsigned*)((const char*)(gbase) + (voff)[_i]), (LAS unsigned*)(lds + (bufoff) + ldsw + _i * 8192), 16, 0, 0); } while (0)
#define PG8_LDA(dst, b, h) do { _Pragma("unroll") for (int m = 0; m < 4; ++m) _Pragma("unroll") for (int k = 0; k < 2; ++k) dst[m][k] = *(const LAS bf16x8*)(lds + PG8_SA(b, h) + aoff + m * 2048 + k * 1024); } while (0)
#define PG8_LDB(dst, b, h) do { _Pragma("unroll") for (int n = 0; n < 2; ++n) _Pragma("unroll") for (int k = 0; k < 2; ++k) dst[n][k] = *(const LAS bf16x8*)(lds + PG8_SB(b, h) + boff + n * 2048 + k * 1024); } while (0)
#define PG8_MMA(ai, bj, At, Bt) do { __builtin_amdgcn_s_setprio(1); _Pragma("unroll") for (int m = 0; m < 4; ++m) _Pragma("unroll") for (int n = 0; n < 2; ++n) _Pragma("unroll") for (int k = 0; k < 2; ++k) \
        acc[ai][bj][m][n] = __builtin_amdgcn_mfma_f32_16x16x32_bf16(Bt[n][k], At[m][k], acc[ai][bj][m][n], 0, 0, 0); __builtin_amdgcn_s_setprio(0); } while (0)
#define PG8_WAIT_V(n) asm volatile("s_waitcnt vmcnt(" #n ")" ::: "memory")
#define PG8_WAIT_L(n) asm volatile("s_waitcnt lgkmcnt(" #n ")" ::: "memory")
#define PG8_BAR __builtin_amdgcn_s_barrier()
#define PG8_SCHED __builtin_amdgcn_sched_barrier(0)
    Unit cur, nxt; int ui = 0;
    if (!S.next(0, cur)) return;
    f32x4 acc[2][2][4][2];
#pragma unroll
    for (int a = 0; a < 2; ++a)
#pragma unroll
        for (int b = 0; b < 2; ++b)
#pragma unroll
            for (int m = 0; m < 4; ++m)
#pragma unroll
                for (int n = 0; n < 2; ++n) acc[a][b][m][n] = (f32x4){0.f, 0.f, 0.f, 0.f};
    bf16x8 At[4][2], B0[2][2], B1[2][2];
    const char* cA = (const char*)g.A + (size_t)cur.pm * tstepA; const char* cB = (const char*)g.Bt + (size_t)cur.pn * tstepB;
    PG8_STAGE(PG8_SB(0, 0), cB, voffB); PG8_STAGE(PG8_SB(0, 1), cB + hstepB, voffB); PG8_STAGE(PG8_SA(0, 0), cA, voffA); PG8_STAGE(PG8_SA(0, 1), cA + hstepA, voffA);
    if (wr == 1) PG8_BAR;
    PG8_WAIT_V(2); PG8_BAR;
    PG8_STAGE(PG8_SB(1, 0), cB + kstep, voffB); PG8_STAGE(PG8_SA(1, 0), cA + kstep, voffA); PG8_STAGE(PG8_SB(1, 1), cB + hstepB + kstep, voffB);
    PG8_WAIT_V(6); PG8_BAR;
    for (;;) {
        const bool has_next = S.next(ui + 1, nxt);
        const char* nA = has_next ? (const char*)g.A + (size_t)nxt.pm * tstepA : cA; const char* nB = has_next ? (const char*)g.Bt + (size_t)nxt.pn * tstepB : cB;
        for (int t = 0; t < nt; t += 2) {
            const bool last = (t == nt - 2);
            const char* a1 = cA + (size_t)(t + 1) * kstep;
            const char* a2 = last ? nA : cA + (size_t)(t + 2) * kstep; const char* b2 = last ? nB : cB + (size_t)(t + 2) * kstep;
            const char* a3 = a2 + kstep; const char* b3 = b2 + kstep;
            PG8_LDB(B0, 0, 0); PG8_LDB(B1, 0, 1); PG8_SCHED; PG8_LDA(At, 0, 0); PG8_STAGE(PG8_SA(1, 1), a1 + hstepA, voffA);
            PG8_WAIT_V(8); PG8_WAIT_L(0); PG8_BAR; PG8_MMA(0, 0, At, B0); PG8_MMA(0, 1, At, B1); PG8_BAR; PG8_SCHED;
            PG8_LDA(At, 0, 1); PG8_STAGE(PG8_SB(0, 0), b2, voffB); PG8_STAGE(PG8_SB(0, 1), b2 + hstepB, voffB); PG8_STAGE(PG8_SA(0, 0), a2, voffA);
            PG8_WAIT_V(8); PG8_WAIT_L(0); PG8_BAR; PG8_MMA(1, 0, At, B0); PG8_MMA(1, 1, At, B1); PG8_BAR; PG8_SCHED;
            PG8_LDB(B0, 1, 0); PG8_LDB(B1, 1, 1); PG8_SCHED; PG8_LDA(At, 1, 0); PG8_STAGE(PG8_SA(0, 1), a2 + hstepA, voffA);
            PG8_WAIT_V(8); PG8_WAIT_L(0); PG8_BAR; PG8_MMA(0, 0, At, B0); PG8_MMA(0, 1, At, B1); PG8_BAR; PG8_SCHED;
            PG8_LDA(At, 1, 1); PG8_STAGE(PG8_SB(1, 0), b3, voffB); PG8_STAGE(PG8_SB(1, 1), b3 + hstepB, voffB); PG8_STAGE(PG8_SA(1, 0), a3, voffA);
            PG8_WAIT_V(8); PG8_WAIT_L(0); PG8_BAR; PG8_MMA(1, 0, At, B0); PG8_MMA(1, 1, At, B1); PG8_BAR; PG8_SCHED;
        }
        if (wr == 0) PG8_BAR;
        E(acc, cur, wr, wc, fr, fq);
        if (!has_next) break;
#pragma unroll
        for (int a = 0; a < 2; ++a)
#pragma unroll
            for (int b = 0; b < 2; ++b)
#pragma unroll
                for (int m = 0; m < 4; ++m)
#pragma unroll
                    for (int n = 0; n < 2; ++n) acc[a][b][m][n] = (f32x4){0.f, 0.f, 0.f, 0.f};
        cur = nxt; cA = nA; cB = nB; ++ui;
        if (wr == 1) PG8_BAR;
    }
    PG8_WAIT_V(0);
    PG8_BAR;
#undef PG8_SA
#undef PG8_SB
#undef PG8_STAGE
#undef PG8_LDA
#undef PG8_LDB
#undef PG8_MMA
#undef PG8_WAIT_V
#undef PG8_WAIT_L
#undef PG8_BAR
#undef PG8_SCHED
}

__device__ __forceinline__ u32x4 pack8(const f32x4& a, const f32x4& b) { u32x4 w; w.x = cvt_pk_bf16_c(a[0], a[1]); w.y = cvt_pk_bf16_c(a[2], a[3]); w.z = cvt_pk_bf16_c(b[0], b[1]); w.w = cvt_pk_bf16_c(b[2], b[3]); return w; }
struct EpiStore {
    bf16_t* O; int ldc;
    __device__ __forceinline__ void operator()(const f32x4 (&acc)[2][2][4][2], const Unit& u, int wr, int wc, int fr, int fq) const {
        const int row0 = u.pm * BM + wr * 64 + fr, col0 = u.pn * BM + wc * 32 + fq * 8;
#pragma unroll
        for (int ai = 0; ai < 2; ++ai)
#pragma unroll
            for (int m = 0; m < 4; ++m) { bf16_t* rp = O + (size_t)(row0 + ai * HALF + m * 16) * ldc + col0;
#pragma unroll
                for (int bj = 0; bj < 2; ++bj) *(u32x4*)(rp + bj * HALF) = pack8(acc[ai][bj][m][0], acc[ai][bj][m][1]); }
    }
};
struct EpiSwiGLU {
    bf16_t* O;
    __device__ __forceinline__ void operator()(const f32x4 (&acc)[2][2][4][2], const Unit& u, int wr, int wc, int fr, int fq) const {
        const int row0 = u.pm * BM + wr * 64 + fr, col0 = u.pn * HALF + wc * 32 + fq * 8;
#pragma unroll
        for (int ai = 0; ai < 2; ++ai)
#pragma unroll
            for (int m = 0; m < 4; ++m) { bf16_t* rp = O + (size_t)(row0 + ai * HALF + m * 16) * FF + col0;
                f32x4 h[2];
#pragma unroll
                for (int n = 0; n < 2; ++n) { const f32x4 gv = acc[ai][0][m][n], uv = acc[ai][1][m][n];
                    h[n] = (f32x4){silu_f(gv[0]) * uv[0], silu_f(gv[1]) * uv[1], silu_f(gv[2]) * uv[2], silu_f(gv[3]) * uv[3]}; }
                *(u32x4*)rp = pack8(h[0], h[1]); }
    }
};
struct EpiUin {
    bf16_t* U; float* dtT; const float* rot; const float* bias_f; const float* bias_b;
    __device__ __forceinline__ void operator()(const f32x4 (&acc)[2][2][4][2], const Unit& u, int wr, int wc, int fr, int fq) const {
        const int row0 = u.pm * BM + wr * 64 + fr;
        if (u.pn == 22) {
            if (wc == 0) {
                const float* bp = (fq < 2) ? (bias_f + fq * 8) : (bias_b + (fq - 2) * 8);
                const f32x4 b0 = *(const f32x4*)bp, b1 = *(const f32x4*)(bp + 4);
                const unsigned vo = (unsigned)(fq * 8) * (unsigned)T + (unsigned)row0;
#pragma unroll
                for (int n = 0; n < 2; ++n)
#pragma unroll
                    for (int e = 0; e < 4; ++e) { float* cb = dtT + (size_t)(n * 4 + e) * T; const float bb = n ? b1[e] : b0[e];
#pragma unroll
                        for (int ai = 0; ai < 2; ++ai)
#pragma unroll
                            for (int m = 0; m < 4; ++m) { const float xv = acc[ai][0][m][n][e] + bb; const float ex = __expf(fminf(xv, 15.f));
                                const float sp = xv > 15.f ? xv : (ex < 0.01f ? ex * (1.f - ex * (0.5f - ex * (1.f / 3.f))) : __logf(1.f + ex));
                                cb[vo + (unsigned)(ai * HALF + m * 16)] = sp; } }
            }
            return;
        }
        const int col0 = u.pn * BM + wc * 32 + fq * 8;
        if (u.pn < 8) {
            const bool rot_ok = ((wc & 1) == 0) && (fq < 2);
#pragma unroll
            for (int ai = 0; ai < 2; ++ai)
#pragma unroll
                for (int m = 0; m < 4; ++m) { const int row = row0 + ai * HALF + m * 16; bf16_t* rp = U + (size_t)row * ULD + col0;
                    const float* rp_ = rot + (size_t)(row & (SEQ - 1)) * 16 + (fq & 1) * 8;
#pragma unroll
                    for (int bj = 0; bj < 2; ++bj) { f32x4 v0 = acc[ai][bj][m][0], v1 = acc[ai][bj][m][1];
                        { f32x4 cs = *(const f32x4*)rp_; if (!rot_ok) cs = (f32x4){1.f, 0.f, 1.f, 0.f};
                          const float a0 = v0[0], a1 = v0[2];
                          v0[0] = a0 * cs[0] - v0[1] * cs[1]; v0[1] = v0[1] * cs[0] + a0 * cs[1]; v0[2] = a1 * cs[2] - v0[3] * cs[3]; v0[3] = v0[3] * cs[2] + a1 * cs[3]; }
                        { f32x4 cs = *(const f32x4*)(rp_ + 4); if (!rot_ok) cs = (f32x4){1.f, 0.f, 1.f, 0.f};
                          const float a0 = v1[0], a1 = v1[2];
                          v1[0] = a0 * cs[0] - v1[1] * cs[1]; v1[1] = v1[1] * cs[0] + a0 * cs[1]; v1[2] = a1 * cs[2] - v1[3] * cs[3]; v1[3] = v1[3] * cs[2] + a1 * cs[3]; }
                        *(u32x4*)(rp + bj * HALF) = pack8(v0, v1); } }
            return;
        }
#pragma unroll
        for (int ai = 0; ai < 2; ++ai)
#pragma unroll
            for (int m = 0; m < 4; ++m) { bf16_t* rp = U + (size_t)(row0 + ai * HALF + m * 16) * ULD + col0;
#pragma unroll
                for (int bj = 0; bj < 2; ++bj) *(u32x4*)(rp + bj * HALF) = pack8(acc[ai][bj][m][0], acc[ai][bj][m][1]); }
    }
};
}

struct Args {
    const float* in[29]; float* out; unsigned char* ws; int ph_lo, ph_hi;
};
enum { I_X = 0, I_F1PRE, I_F1G, I_F1U, I_F1D, I_F1POST, I_MIXPRE, I_WIN, I_LQ1, I_LK1, I_LQ2, I_LK2, I_SUBLN, I_CONVW, I_CONVB, I_ALOGF, I_ALOGB, I_DTBF, I_DTBB,
       I_DSKIP, I_SSDG, I_WOUT, I_MIXPOST, I_F2PRE, I_F2G, I_F2U, I_F2D, I_F2POST, I_FINAL };

__device__ __forceinline__ int dst_row(int mode, int row_off, int n) {
    if (mode == 0) return row_off + n;
    if (mode == 1) return (n >> 7) * 256 + (n & 127) + row_off;
    if (n < 2048) { const int j = n & 63; if (j < 16) return (n & ~63) + ((j < 8) ? 2 * j : 2 * (j - 8) + 1); }
    return n;
}
__device__ __forceinline__ void p0_transpose_item(const float* W, int K, int N, bf16_t* WT, int mode, int row_off, LAS float* scr, int item, int lane) {
    const int nblk = N / 32, kb = item / nblk, nb = item % nblk, k0 = 64 * kb, n0 = 32 * nb;
    { f32x4 t[8];
#pragma unroll
      for (int i = 0; i < 8; ++i) t[i] = *(const f32x4*)(W + (size_t)(k0 + 8 * i + (lane >> 3)) * N + n0 + (lane & 7) * 4);
#pragma unroll
      for (int i = 0; i < 8; ++i) { LAS float* d = scr + (8 * i + (lane >> 3)) * 33 + (lane & 7) * 4; d[0] = t[i][0]; d[1] = t[i][1]; d[2] = t[i][2]; d[3] = t[i][3]; } }
    asm volatile("s_waitcnt lgkmcnt(0)" ::: "memory");
    const int c = lane & 7;
#pragma unroll
    for (int j = 0; j < 4; ++j) { const int n = (lane >> 3) + 8 * j; const LAS float* s = scr + (8 * c) * 33 + n;
        u32x4 o; o.x = cvt_pk_bf16(s[0 * 33], s[1 * 33]); o.y = cvt_pk_bf16(s[2 * 33], s[3 * 33]); o.z = cvt_pk_bf16(s[4 * 33], s[5 * 33]); o.w = cvt_pk_bf16(s[6 * 33], s[7 * 33]);
        *(u32x4*)(WT + (size_t)dst_row(mode, row_off, n0 + n) * K + k0 + 8 * c) = o; }
    asm volatile("s_waitcnt lgkmcnt(0)" ::: "memory");
}

struct Row { f32x4 v[4]; };
__device__ __forceinline__ Row ld_row_f32(const float* p, int lane) { Row r; const f32x4* q = (const f32x4*)p + lane * 2;
#pragma unroll
    for (int j = 0; j < 2; ++j) { r.v[2 * j] = q[128 * j]; r.v[2 * j + 1] = q[128 * j + 1]; } return r; }
__device__ __forceinline__ Row ld_row_bf16(const bf16_t* p, int lane) { Row r; const u32x4* q = (const u32x4*)p + lane;
#pragma unroll
    for (int j = 0; j < 2; ++j) { const u32x4 w = q[64 * j]; r.v[2 * j] = (f32x4){bf_lo(w.x), bf_hi(w.x), bf_lo(w.y), bf_hi(w.y)}; r.v[2 * j + 1] = (f32x4){bf_lo(w.z), bf_hi(w.z), bf_lo(w.w), bf_hi(w.w)}; } return r; }
__device__ __forceinline__ void st_row_f32(float* p, int lane, const Row& r) { f32x4* q = (f32x4*)p + lane * 2;
#pragma unroll
    for (int j = 0; j < 2; ++j) { q[128 * j] = r.v[2 * j]; q[128 * j + 1] = r.v[2 * j + 1]; } }
__device__ __forceinline__ void st_row_bf16(bf16_t* p, int lane, const Row& r) { u32x4* q = (u32x4*)p + lane;
#pragma unroll
    for (int j = 0; j < 2; ++j) { u32x4 w; w.x = cvt_pk_bf16(r.v[2 * j][0], r.v[2 * j][1]); w.y = cvt_pk_bf16(r.v[2 * j][2], r.v[2 * j][3]);
        w.z = cvt_pk_bf16(r.v[2 * j + 1][0], r.v[2 * j + 1][1]); w.w = cvt_pk_bf16(r.v[2 * j + 1][2], r.v[2 * j + 1][3]); q[64 * j] = w; } }
__device__ __forceinline__ float row_ss(const Row& r) { float s = 0.f;
#pragma unroll
    for (int j = 0; j < 4; ++j) s += (r.v[j][0] * r.v[j][0] + r.v[j][1] * r.v[j][1]) + (r.v[j][2] * r.v[j][2] + r.v[j][3] * r.v[j][3]);
    return wave_sum(s); }
__device__ __forceinline__ float rs_of(float ss) { return 1.0f / sqrtf(ss * (1.0f / DM) + EPS); }

__device__ __forceinline__ void p0_prologue(const Args& a, LAS unsigned char* lds, int gw, int NGW, int wave, int lane) {
    unsigned char* ws = a.ws;
    LAS float* scr = (LAS float*)(lds + wave * 16384);
    constexpr int I_GU = (DM / 64) * (FF / 32), I_D = (FF / 64) * (DM / 32), I_IN = (DM / 64) * (5664 / 32), I_OUT = (2048 / 64) * (DM / 32);
    constexpr int NITEMS = 4 * I_GU + 2 * I_D + I_IN + I_OUT;
    for (int it = gw; it < NITEMS; it += NGW) {
        int r = it;
        if (r < I_GU) { p0_transpose_item(a.in[I_F1G], DM, FF, (bf16_t*)(ws + WS_W1), 1, 0, scr, r, lane); continue; } r -= I_GU;
        if (r < I_GU) { p0_transpose_item(a.in[I_F1U], DM, FF, (bf16_t*)(ws + WS_W1), 1, 128, scr, r, lane); continue; } r -= I_GU;
        if (r < I_GU) { p0_transpose_item(a.in[I_F2G], DM, FF, (bf16_t*)(ws + WS_W2), 1, 0, scr, r, lane); continue; } r -= I_GU;
        if (r < I_GU) { p0_transpose_item(a.in[I_F2U], DM, FF, (bf16_t*)(ws + WS_W2), 1, 128, scr, r, lane); continue; } r -= I_GU;
        if (r < I_D) { p0_transpose_item(a.in[I_F1D], FF, DM, (bf16_t*)(ws + WS_WD1), 0, 0, scr, r, lane); continue; } r -= I_D;
        if (r < I_D) { p0_transpose_item(a.in[I_F2D], FF, DM, (bf16_t*)(ws + WS_WD2), 0, 0, scr, r, lane); continue; } r -= I_D;
        if (r < I_IN) { p0_transpose_item(a.in[I_WIN], DM, 5664, (bf16_t*)(ws + WS_WIN), 2, 0, scr, r, lane); continue; } r -= I_IN;
        p0_transpose_item(a.in[I_WOUT], 2048, DM, (bf16_t*)(ws + WS_WOUT), 0, 0, scr, r, lane);
    }
    { u32x4* z = (u32x4*)(ws + WS_WIN + (size_t)5664 * DM * 2); const int n16 = 224 * 2048 / 16;
      for (int i = gw * 64 + lane; i < n16; i += NGW * 64) z[i] = (u32x4){0u, 0u, 0u, 0u}; }
    { float* rot = (float*)(ws + WS_ROT);
      for (int i = gw * 64 + lane; i < SEQ * 8; i += NGW * 64) { const int pos = i >> 3, f = i & 7;
          const float inv = powf(500000.0f, -(float)(2 * f) / 16.0f); const float ang = (float)pos * inv; rot[2 * i] = cosf(ang); rot[2 * i + 1] = sinf(ang); } }
    if (gw == 0) { const float q1 = a.in[I_LQ1][lane] * a.in[I_LK1][lane], q2 = a.in[I_LQ2][lane] * a.in[I_LK2][lane];
        const float s1 = wave_sum(q1), s2 = wave_sum(q2); if (lane == 0) *(float*)(ws + WS_LAM) = expf(s1) - expf(s2) + 0.2f; }
    const Row g = ld_row_f32(a.in[I_F1PRE], lane);
    bf16_t* XN = (bf16_t*)(ws + WS_XN);
    for (int m0 = gw; m0 < T; m0 += 2 * NGW) {
        Row x[2];
#pragma unroll
        for (int u = 0; u < 2; ++u) { const int m = min(m0 + u * NGW, T - 1); x[u] = ld_row_f32(a.in[I_X] + (size_t)m * DM, lane); }
#pragma unroll
        for (int u = 0; u < 2; ++u) { const int m = m0 + u * NGW; const float rs = rs_of(row_ss(x[u]));
#pragma unroll
            for (int j = 0; j < 4; ++j) x[u].v[j] = x[u].v[j] * rs * g.v[j];
            if (m < T) st_row_bf16(XN + (size_t)m * DM, lane, x[u]); }
    }
}

constexpr int RU = 2, RU4 = 4;
__device__ __forceinline__ void p3_rows(const Args& a, int gw, int NGW, int lane) {
    const Row gp = ld_row_f32(a.in[I_F1POST], lane), gm = ld_row_f32(a.in[I_MIXPRE], lane);
    const bf16_t* F = (const bf16_t*)(a.ws + WS_F); bf16_t* XN = (bf16_t*)(a.ws + WS_XN);
    for (int m0 = gw; m0 < T; m0 += RU * NGW) {
        Row x[RU], f[RU];
#pragma unroll
        for (int u = 0; u < RU; ++u) { const int m = min(m0 + u * NGW, T - 1); x[u] = ld_row_f32(a.in[I_X] + (size_t)m * DM, lane); f[u] = ld_row_bf16(F + (size_t)m * DM, lane); }
#pragma unroll
        for (int u = 0; u < RU; ++u) { const int m = m0 + u * NGW;
            const float rs = 0.5f * rs_of(row_ss(f[u]));
#pragma unroll
            for (int j = 0; j < 4; ++j) x[u].v[j] = x[u].v[j] + f[u].v[j] * rs * gp.v[j];
            if (m < T) st_row_bf16((bf16_t*)F + (size_t)m * DM, lane, x[u]);
            const float r2 = rs_of(row_ss(x[u]));
#pragma unroll
            for (int j = 0; j < 4; ++j) x[u].v[j] = x[u].v[j] * r2 * gm.v[j];
            if (m < T) st_row_bf16(XN + (size_t)m * DM, lane, x[u]); }
    }
}
__device__ __forceinline__ void p7_rows(const Args& a, int gw, int NGW, int lane) {
    const Row g = ld_row_f32(a.in[I_SSDG], lane);
    bf16_t* U = (bf16_t*)(a.ws + WS_BIG); const bf16_t* YB = (const bf16_t*)(a.ws + WS_XN);
    for (int m0 = gw; m0 < T; m0 += RU * NGW) {
        Row yf[RU], yb[RU], z[RU];
#pragma unroll
        for (int u = 0; u < RU; ++u) { const int m = min(m0 + u * NGW, T - 1);
            yf[u] = ld_row_bf16(U + (size_t)m * ULD + 4096, lane); yb[u] = ld_row_bf16(YB + (size_t)m * DM, lane); z[u] = ld_row_bf16(U + (size_t)m * ULD + 3072, lane); }
#pragma unroll
        for (int u = 0; u < RU; ++u) { const int m = m0 + u * NGW;
#pragma unroll
            for (int j = 0; j < 4; ++j)
#pragma unroll
                for (int e = 0; e < 4; ++e) yf[u].v[j][e] = (yf[u].v[j][e] + yb[u].v[j][e]) * silu_f(z[u].v[j][e]);
            const float rs = rs_of(row_ss(yf[u]));
#pragma unroll
            for (int j = 0; j < 4; ++j) yf[u].v[j] = yf[u].v[j] * rs * g.v[j];
            if (m < T) st_row_bf16(U + (size_t)m * ULD + 1024, lane, yf[u]); }
    }
}
__device__ __forceinline__ void p9_rows(const Args& a, int gw, int NGW, int lane) {
    const Row gm = ld_row_f32(a.in[I_MIXPOST], lane), g2 = ld_row_f32(a.in[I_F2PRE], lane);
    const bf16_t* H1 = (const bf16_t*)(a.ws + WS_F); const bf16_t* Mx = (const bf16_t*)(a.ws + WS_XN); bf16_t* XN3 = (bf16_t*)(a.ws + WS_XN3);
    for (int m0 = gw; m0 < T; m0 += RU4 * NGW) {
        Row x[RU4], mm[RU4];
#pragma unroll
        for (int u = 0; u < RU4; ++u) { const int m = min(m0 + u * NGW, T - 1);
            x[u] = ld_row_bf16(H1 + (size_t)m * DM, lane); mm[u] = ld_row_bf16(Mx + (size_t)m * DM, lane); }
#pragma unroll
        for (int u = 0; u < RU4; ++u) { const int m = m0 + u * NGW;
            const float rm = rs_of(row_ss(mm[u]));
#pragma unroll
            for (int j = 0; j < 4; ++j) x[u].v[j] = x[u].v[j] + mm[u].v[j] * rm * gm.v[j];
            if (m < T) st_row_f32(a.out + (size_t)m * DM, lane, x[u]);
            const float r2 = rs_of(row_ss(x[u]));
#pragma unroll
            for (int j = 0; j < 4; ++j) x[u].v[j] = x[u].v[j] * r2 * g2.v[j];
            if (m < T) st_row_bf16(XN3 + (size_t)m * DM, lane, x[u]); }
    }
}
__device__ __forceinline__ void p12_rows(const Args& a, int gw, int NGW, int lane) {
    const Row gp = ld_row_f32(a.in[I_F2POST], lane), gf = ld_row_f32(a.in[I_FINAL], lane);
    const bf16_t* F = (const bf16_t*)(a.ws + WS_F);
    for (int m0 = gw; m0 < T; m0 += RU * NGW) {
        Row x[RU], f[RU];
#pragma unroll
        for (int u = 0; u < RU; ++u) { const int m = min(m0 + u * NGW, T - 1); x[u] = ld_row_f32(a.out + (size_t)m * DM, lane); f[u] = ld_row_bf16(F + (size_t)m * DM, lane); }
#pragma unroll
        for (int u = 0; u < RU; ++u) { const int m = m0 + u * NGW;
            const float rs = 0.5f * rs_of(row_ss(f[u]));
#pragma unroll
            for (int j = 0; j < 4; ++j) x[u].v[j] = x[u].v[j] + f[u].v[j] * rs * gp.v[j];
            const float r2 = rs_of(row_ss(x[u]));
#pragma unroll
            for (int j = 0; j < 4; ++j) x[u].v[j] = x[u].v[j] * r2 * gf.v[j];
            if (m < T) st_row_f32(a.out + (size_t)m * DM, lane, x[u]); }
    }
}

constexpr int TPAD = 136;
__device__ __forceinline__ void p5_conv(const Args& a, LAS unsigned char* lds) {
    const int tid = threadIdx.x, co = tid & 7, tg = tid >> 3;
    const bf16_t* U = (const bf16_t*)(a.ws + WS_BIG);
    bf16_t* XT = (bf16_t*)((unsigned char*)a.out + DO_XT); bf16_t* BM = (bf16_t*)((unsigned char*)a.out + DO_BM);
    bf16_t* BMT = (bf16_t*)((unsigned char*)a.out + DO_BMT); bf16_t* CM = (bf16_t*)((unsigned char*)a.out + DO_CM);
    LAS bf16_t* Tt = (LAS bf16_t*)lds;
    const float* cw = a.in[I_CONVW]; const float* cb = a.in[I_CONVB];
    const int l0 = 2 * tg;
    constexpr int NITEM = NB * 16 * 24;
    u32x4 raw[6];
#define P5_LOAD(item_) do { const int cg_ = (item_) / (NB * 16), bc_ = (item_) % (NB * 16), c_ = bc_ & 15, b_ = bc_ >> 4; \
    const int ch0_ = (cg_ < 16) ? cg_ * 64 : (cg_ < 20 ? 1024 + (cg_ - 16) * 64 : 1280 + (cg_ - 20) * 64); \
    _Pragma("unroll") for (int j = 0; j < 6; ++j) { const int tt = c_ * 128 + l0 + j - 2; raw[j] = (u32x4){0u, 0u, 0u, 0u}; \
        if (tt >= 0 && tt < SEQ) raw[j] = *(const u32x4*)(U + (size_t)(b_ * SEQ + tt) * ULD + 4096 + ch0_ + co * 8); } } while (0)
    int item = blockIdx.x;
    if (item < NITEM) P5_LOAD(item);
    for (; item < NITEM; item += gridDim.x) {
        const int cg = item / (NB * 16), bc = item % (NB * 16), c = bc & 15, b = bc >> 4;
        const int ch0 = (cg < 16) ? cg * 64 : (cg < 20 ? 1024 + (cg - 16) * 64 : 1280 + (cg - 20) * 64);
        const int chn = ch0 + co * 8;
        u32x4 cur[6];
#pragma unroll
        for (int j = 0; j < 6; ++j) cur[j] = raw[j];
        if (item + (int)gridDim.x < NITEM) P5_LOAD(item + (int)gridDim.x);
        float wv[5][8], bv[8];
#pragma unroll
        for (int j = 0; j < 5; ++j) { const f32x4 w0 = *(const f32x4*)(cw + (size_t)j * 1536 + chn), w1 = *(const f32x4*)(cw + (size_t)j * 1536 + chn + 4);
#pragma unroll
            for (int e = 0; e < 4; ++e) { wv[j][e] = w0[e]; wv[j][4 + e] = w1[e]; } }
        { const f32x4 b0 = *(const f32x4*)(cb + chn), b1 = *(const f32x4*)(cb + chn + 4);
#pragma unroll
          for (int e = 0; e < 4; ++e) { bv[e] = b0[e]; bv[4 + e] = b1[e]; } }
        float o0[8], o1[8];
#pragma unroll
        for (int e = 0; e < 8; ++e) { o0[e] = bv[e]; o1[e] = bv[e]; }
#pragma unroll
        for (int j = 0; j < 6; ++j) {
            const u32x4 w = cur[j];
            float xv[8] = {bf_lo(w.x), bf_hi(w.x), bf_lo(w.y), bf_hi(w.y), bf_lo(w.z), bf_hi(w.z), bf_lo(w.w), bf_hi(w.w)};
            if (j < 5) {
#pragma unroll
                for (int e = 0; e < 8; ++e) o0[e] += wv[j][e] * xv[e]; }
            if (j >= 1) {
#pragma unroll
                for (int e = 0; e < 8; ++e) o1[e] += wv[j - 1][e] * xv[e]; }
        }
#pragma unroll
        for (int e = 0; e < 8; ++e) { o0[e] = silu_f(o0[e]); o1[e] = silu_f(o1[e]); }
        u32x4 p0, p1;
        p0.x = cvt_pk_bf16(o0[0], o0[1]); p0.y = cvt_pk_bf16(o0[2], o0[3]); p0.z = cvt_pk_bf16(o0[4], o0[5]); p0.w = cvt_pk_bf16(o0[6], o0[7]);
        p1.x = cvt_pk_bf16(o1[0], o1[1]); p1.y = cvt_pk_bf16(o1[2], o1[3]); p1.z = cvt_pk_bf16(o1[4], o1[5]); p1.w = cvt_pk_bf16(o1[6], o1[7]);
        const int t0 = c * 128;
        if (cg >= 16) {
            const int q = (cg - 16) & 3, g = q >> 1, n0 = (q & 1) * 64 + co * 8;
            bf16_t* D = (cg < 20 ? BM : CM) + ((size_t)(b * 2 + g) * SEQ + t0 + l0) * 128 + n0;
            *(u32x4*)D = p0; *(u32x4*)(D + 128) = p1;
        }
        if (cg < 20) {
            const unsigned pw[4] = {p0.x, p0.y, p0.z, p0.w}, qw[4] = {p1.x, p1.y, p1.z, p1.w};
#pragma unroll
            for (int e = 0; e < 8; ++e) { const unsigned lo = (e & 1) ? (pw[e >> 1] >> 16) : (pw[e >> 1] & 0xffffu), hi = (e & 1) ? (qw[e >> 1] >> 16) : (qw[e >> 1] & 0xffffu);
                *(LAS unsigned*)(Tt + (co * 8 + e) * TPAD + l0) = lo | (hi << 16); }
            __syncthreads();
            bf16_t* D; if (cg < 16) D = XT + ((size_t)(b * 16 + cg) * 64) * SEQ + t0; else { const int q = cg - 16, g = q >> 1; D = BMT + ((size_t)(b * 2 + g) * 128 + (q & 1) * 64) * SEQ + t0; }
#pragma unroll
            for (int i = 0; i < 2; ++i) { const int qq = tid + 512 * i, ch = qq >> 4, seg = qq & 15;
                *(u32x4*)(D + (size_t)ch * SEQ + seg * 8) = *(const LAS u32x4*)(Tt + ch * TPAD + seg * 8); }
            __syncthreads();
        }
    }
#undef P5_LOAD
}

constexpr int SS_XT = 0, SS_BM = 64 * TPAD * 2, SS_BMT = SS_BM + 128 * TPAD * 2, SS_CM = SS_BMT + 128 * TPAD * 2, SS_SB = SS_CM + 128 * TPAD * 2,
              SS_SC = SS_SB + 64 * TPAD * 2, SS_END = SS_SC + 2048;
static_assert(SS_END <= LDS_BYTES - 512, "ssd lds");
__device__ __forceinline__ void ssd_unit(const Args& a, LAS unsigned char* lds, int b, int h, int dir) {
    const int tid = threadIdx.x, w = __builtin_amdgcn_readfirstlane(tid >> 6), lane = tid & 63, fr = lane & 15, fq = lane >> 4;
    LAS bf16_t* sXt = (LAS bf16_t*)(lds + SS_XT); LAS bf16_t* sBm = (LAS bf16_t*)(lds + SS_BM);
    LAS bf16_t* sBmt = (LAS bf16_t*)(lds + SS_BMT); LAS bf16_t* sCm = (LAS bf16_t*)(lds + SS_CM); LAS bf16_t* sSb = (LAS bf16_t*)(lds + SS_SB);
    LAS float* sDt = (LAS float*)(lds + SS_SC); LAS float* sCs = sDt + 128; LAS float* sW = sDt + 256; LAS float* sTot = sDt + 384;
    const int g = h >> 3;
    const bf16_t* XT = (const bf16_t*)((const unsigned char*)a.out + DO_XT) + ((size_t)(b * 16 + h) * 64) * SEQ;
    const bf16_t* BM = (const bf16_t*)((const unsigned char*)a.out + DO_BM) + ((size_t)(b * 2 + g) * SEQ) * 128;
    const bf16_t* BMT = (const bf16_t*)((const unsigned char*)a.out + DO_BMT) + ((size_t)(b * 2 + g) * 128) * SEQ;
    const bf16_t* CM = (const bf16_t*)((const unsigned char*)a.out + DO_CM) + ((size_t)(b * 2 + g) * SEQ) * 128;
    const float* dtT = (const float*)(a.ws + WS_DTT) + (size_t)(dir * 16 + h) * T + (size_t)b * SEQ;
    const float* alp = dir ? a.in[I_ALOGB] : a.in[I_ALOGF]; const float aneg = -expf(alp[h]);
    const float dsk = dir ? 0.f : a.in[I_DSKIP][h];
    bf16_t* Y; int ldy;
    if (dir == 0) { Y = (bf16_t*)(a.ws + WS_BIG) + 4096 + h * 64; ldy = ULD; } else { Y = (bf16_t*)(a.ws + WS_XN) + h * 64; ldy = DM; }
    Y += (size_t)b * SEQ * ldy;
    f32x4 accS[4];
#pragma unroll
    for (int i = 0; i < 4; ++i) accS[i] = (f32x4){0.f, 0.f, 0.f, 0.f};
    const int r16 = tid >> 4, seg8 = (tid & 15) * 8;
    u32x4 rX[2], rB[4], rC[4], rT[4]; float rd0, rd1;
#define SSD_LOAD(t0_) do { \
    _Pragma("unroll") for (int i = 0; i < 2; ++i) rX[i] = *(const u32x4*)(XT + (size_t)(r16 + 32 * i) * SEQ + (t0_) + seg8); \
    _Pragma("unroll") for (int i = 0; i < 4; ++i) { rB[i] = *(const u32x4*)(BM + (size_t)((t0_) + r16 + 32 * i) * 128 + seg8); \
        rC[i] = *(const u32x4*)(CM + (size_t)((t0_) + r16 + 32 * i) * 128 + seg8); rT[i] = *(const u32x4*)(BMT + (size_t)(r16 + 32 * i) * SEQ + (t0_) + seg8); } \
    rd0 = dtT[(t0_) + lane]; rd1 = dtT[(t0_) + 64 + lane]; } while (0)
    SSD_LOAD(dir ? 15 * 128 : 0);
    for (int k = 0; k < 16; ++k) {
        const int c = dir ? 15 - k : k, t0 = c * 128;
        __syncthreads();
#pragma unroll
        for (int pb = 0; pb < 4; ++pb) { u32x2 wv; wv.x = cvt_pk_bf16(accS[pb][0], accS[pb][1]); wv.y = cvt_pk_bf16(accS[pb][2], accS[pb][3]);
            *(LAS u32x2*)(sSb + (16 * pb + fr) * TPAD + 16 * w + fq * 4) = wv; }
#pragma unroll
        for (int i = 0; i < 2; ++i) *(LAS u32x4*)(sXt + (r16 + 32 * i) * TPAD + seg8) = rX[i];
#pragma unroll
        for (int i = 0; i < 4; ++i) { *(LAS u32x4*)(sBm + (r16 + 32 * i) * TPAD + seg8) = rB[i]; *(LAS u32x4*)(sCm + (r16 + 32 * i) * TPAD + seg8) = rC[i];
            *(LAS u32x4*)(sBmt + (r16 + 32 * i) * TPAD + seg8) = rT[i]; }
        if (w == 0) {
            const float d0 = rd0, d1 = rd1;
            const float a0 = d0 * aneg, a1 = d1 * aneg;
            float s0 = a0, s1 = a1;
#pragma unroll
            for (int o = 1; o < 64; o <<= 1) { const float u0 = __shfl_up(s0, o), u1 = __shfl_up(s1, o); if (lane >= o) { s0 += u0; s1 += u1; } }
            const float h0 = __shfl(s0, 63); s1 += h0; const float tot = __shfl(s1, 63);
            float c0 = s0, c1 = s1;
            if (dir) { c0 = tot - (s0 - a0); c1 = tot - (s1 - a1); }
            sDt[lane] = d0; sDt[64 + lane] = d1; sCs[lane] = c0; sCs[64 + lane] = c1;
            sW[lane] = d0 * __expf(tot - c0); sW[64 + lane] = d1 * __expf(tot - c1);
            if (lane == 0) sTot[0] = tot;
        }
        if (k + 1 < 16) { const int tn = (dir ? 14 - k : k + 1) * 128; SSD_LOAD(tn); }
        __syncthreads();
        const int l = 16 * w + fr;
        const float csl = sCs[l];
        bf16x8 cf[4];
#pragma unroll
        for (int ks = 0; ks < 4; ++ks) cf[ks] = *(const LAS bf16x8*)(sCm + l * TPAD + 32 * ks + fq * 8);
        f32x4 yo[4];
#pragma unroll
        for (int pb = 0; pb < 4; ++pb) { f32x4 acc = (f32x4){0.f, 0.f, 0.f, 0.f};
#pragma unroll
            for (int ks = 0; ks < 4; ++ks) { const bf16x8 sf = *(const LAS bf16x8*)(sSb + (16 * pb + fr) * TPAD + 32 * ks + fq * 8); acc = __builtin_amdgcn_mfma_f32_16x16x32_bf16(sf, cf[ks], acc, 0, 0, 0); }
            yo[pb] = acc; }
#pragma unroll
        for (int sb = 0; sb < 8; ++sb) {
            const bool need = dir ? (sb >= w) : (sb <= w);
            u32x2 wv = (u32x2){0u, 0u};
            if (need) { f32x4 gacc = (f32x4){0.f, 0.f, 0.f, 0.f};
#pragma unroll
                for (int ks = 0; ks < 4; ++ks) { const bf16x8 bfm = *(const LAS bf16x8*)(sBm + (16 * sb + fr) * TPAD + 32 * ks + fq * 8); gacc = __builtin_amdgcn_mfma_f32_16x16x32_bf16(bfm, cf[ks], gacc, 0, 0, 0); }
                const int s0 = 16 * sb + fq * 4; const f32x4 css = *(const LAS f32x4*)(sCs + s0), dts = *(const LAS f32x4*)(sDt + s0);
                float mv[4];
#pragma unroll
                for (int r = 0; r < 4; ++r) { const int s = s0 + r; const bool ok = dir ? (s >= l) : (s <= l); const float e = __expf(fminf(csl - css[r], 0.f)); mv[r] = ok ? gacc[r] * e * dts[r] : 0.f; }
                wv.x = cvt_pk_bf16(mv[0], mv[1]); wv.y = cvt_pk_bf16(mv[2], mv[3]); }
            *(LAS u32x2*)(sCm + l * TPAD + 16 * sb + fq * 4) = wv; }
        bf16x8 mf[4];
#pragma unroll
        for (int ks = 0; ks < 4; ++ks) mf[ks] = *(const LAS bf16x8*)(sCm + l * TPAD + 32 * ks + fq * 8);
        const float el = __expf(csl);
        bf16_t* yrow = Y + (size_t)(t0 + l) * ldy;
#pragma unroll
        for (int pb = 0; pb < 4; ++pb) { f32x4 acc = (f32x4){0.f, 0.f, 0.f, 0.f};
#pragma unroll
            for (int ks = 0; ks < 4; ++ks) { const bf16x8 xf = *(const LAS bf16x8*)(sXt + (16 * pb + fr) * TPAD + 32 * ks + fq * 8); acc = __builtin_amdgcn_mfma_f32_16x16x32_bf16(xf, mf[ks], acc, 0, 0, 0); }
            float yv[4];
#pragma unroll
            for (int r = 0; r < 4; ++r) yv[r] = acc[r] + el * yo[pb][r] + dsk * bf1(sXt[(16 * pb + fq * 4 + r) * TPAD + l]);
            u32x2 wv; wv.x = cvt_pk_bf16(yv[0], yv[1]); wv.y = cvt_pk_bf16(yv[2], yv[3]);
            *(u32x2*)(yrow + 16 * pb + fq * 4) = wv; }
        const float dec = __expf(sTot[0]);
        bf16x8 bt[4];
#pragma unroll
        for (int ks = 0; ks < 4; ++ks) { const u32x4 raw = *(const LAS u32x4*)(sBmt + (16 * w + fr) * TPAD + 32 * ks + fq * 8);
            const f32x4 w0 = *(const LAS f32x4*)(sW + 32 * ks + fq * 8), w1 = *(const LAS f32x4*)(sW + 32 * ks + fq * 8 + 4);
            u32x4 o; o.x = cvt_pk_bf16(bf_lo(raw.x) * w0[0], bf_hi(raw.x) * w0[1]); o.y = cvt_pk_bf16(bf_lo(raw.y) * w0[2], bf_hi(raw.y) * w0[3]);
            o.z = cvt_pk_bf16(bf_lo(raw.z) * w1[0], bf_hi(raw.z) * w1[1]); o.w = cvt_pk_bf16(bf_lo(raw.w) * w1[2], bf_hi(raw.w) * w1[3]);
            bt[ks] = __builtin_bit_cast(bf16x8, o); }
#pragma unroll
        for (int pb = 0; pb < 4; ++pb) { f32x4 acc = accS[pb] * dec;
#pragma unroll
            for (int ks = 0; ks < 4; ++ks) { const bf16x8 xw = *(const LAS bf16x8*)(sXt + (16 * pb + fr) * TPAD + 32 * ks + fq * 8); acc = __builtin_amdgcn_mfma_f32_16x16x32_bf16(bt[ks], xw, acc, 0, 0, 0); }
            accS[pb] = acc; }
    }
#undef SSD_LOAD
}

constexpr int S4_SC = SS_SB + 64 * TPAD * 2, S4_END = S4_SC + 4 * 384 * 4;
static_assert(S4_END <= LDS_BYTES - 512, "ssd4 lds");
constexpr int NHU = 4;
__device__ __forceinline__ void ssd_unit4(const Args& a, LAS unsigned char* lds, int b, int g, int dir, int hq) {
    const int tid = threadIdx.x, w = __builtin_amdgcn_readfirstlane(tid >> 6), lane = tid & 63, fr = lane & 15, fq = lane >> 4;
    LAS bf16_t* sXt = (LAS bf16_t*)(lds + SS_XT); LAS bf16_t* sBm = (LAS bf16_t*)(lds + SS_BM);
    LAS bf16_t* sBmt = (LAS bf16_t*)(lds + SS_BMT); LAS bf16_t* sCm = (LAS bf16_t*)(lds + SS_CM); LAS bf16_t* sSb = (LAS bf16_t*)(lds + SS_SB);
    LAS float* sSc = (LAS float*)(lds + S4_SC);
    const int h0 = g * 8 + hq * NHU;
    const bf16_t* XT = (const bf16_t*)((const unsigned char*)a.out + DO_XT) + ((size_t)(b * 16 + h0) * 64) * SEQ;
    const bf16_t* BM = (const bf16_t*)((const unsigned char*)a.out + DO_BM) + ((size_t)(b * 2 + g) * SEQ) * 128;
    const bf16_t* BMT = (const bf16_t*)((const unsigned char*)a.out + DO_BMT) + ((size_t)(b * 2 + g) * 128) * SEQ;
    const bf16_t* CM = (const bf16_t*)((const unsigned char*)a.out + DO_CM) + ((size_t)(b * 2 + g) * SEQ) * 128;
    const float* dtT = (const float*)(a.ws + WS_DTT) + (size_t)(dir * 16 + h0 + (w % NHU)) * T + (size_t)b * SEQ;
    const float* alp = dir ? a.in[I_ALOGB] : a.in[I_ALOGF]; const float aneg = -expf(alp[h0 + (w % NHU)]);
    const int ldy = dir ? DM : ULD;
    const __amdgpu_buffer_rsrc_t rsW = __builtin_amdgcn_make_buffer_rsrc((void*)a.ws, 0, 0x7fffffff, 0x00020000);
    const unsigned uY = dir ? (unsigned)(WS_XN + ((size_t)b * SEQ * DM + h0 * 64) * 2) : (unsigned)(WS_BIG + ((size_t)b * SEQ * ULD + 4096 + h0 * 64) * 2);
    f32x4 accS[NHU][4];
#pragma unroll
    for (int j = 0; j < NHU; ++j)
#pragma unroll
        for (int i = 0; i < 4; ++i) accS[j][i] = (f32x4){0.f, 0.f, 0.f, 0.f};
    const int r16 = tid >> 4, seg8 = (tid & 15) * 8;
    u32x4 rX[2], rB[4], rC[4], rT[4];
    const unsigned ob = (unsigned)(r16 * 128 + seg8) * 2u, obT = (unsigned)(r16 * SEQ + seg8) * 2u;
    const __amdgpu_buffer_rsrc_t rsrc = __builtin_amdgcn_make_buffer_rsrc((void*)a.out, 0, 0x7fffffff, 0x00020000);
    const unsigned uBM = (unsigned)(DO_BM + ((size_t)(b * 2 + g) * SEQ) * 128 * 2), uCM = (unsigned)(DO_CM + ((size_t)(b * 2 + g) * SEQ) * 128 * 2);
    const unsigned uBMT = (unsigned)(DO_BMT + ((size_t)(b * 2 + g) * 128) * SEQ * 2), uXT = (unsigned)(DO_XT + ((size_t)(b * 16 + h0) * 64) * SEQ * 2);
#define S4_LOAD_BC(t0_) do { \
    _Pragma("unroll") for (int i = 0; i < 4; ++i) { rB[i] = __builtin_amdgcn_raw_buffer_load_b128(rsrc, ob, uBM + (unsigned)((t0_) + 32 * i) * 256u, 0); \
        rC[i] = __builtin_amdgcn_raw_buffer_load_b128(rsrc, ob, uCM + (unsigned)((t0_) + 32 * i) * 256u, 0); \
        rT[i] = __builtin_amdgcn_raw_buffer_load_b128(rsrc, obT, uBMT + (unsigned)(32 * i) * (SEQ * 2u) + (unsigned)(t0_) * 2u, 0); } } while (0)
#define S4_LOAD_X(j_, t0_) do { _Pragma("unroll") for (int i = 0; i < 2; ++i) rX[i] = __builtin_amdgcn_raw_buffer_load_b128(rsrc, obT, uXT + (unsigned)((j_) * 64 + 32 * i) * (SEQ * 2u) + (unsigned)(t0_) * 2u, 0); } while (0)
#define S4_STAGE_X() do { _Pragma("unroll") for (int i = 0; i < 2; ++i) *(LAS u32x4*)(sXt + (r16 + 32 * i) * TPAD + seg8) = rX[i]; } while (0)
#define S4_STAGE_SB(j_) do { _Pragma("unroll") for (int pb = 0; pb < 4; ++pb) { u32x2 wv; wv.x = cvt_pk_bf16_c(accS[j_][pb][0], accS[j_][pb][1]); wv.y = cvt_pk_bf16_c(accS[j_][pb][2], accS[j_][pb][3]); \
        *(LAS u32x2*)(sSb + (16 * pb + fr) * TPAD + 16 * w + fq * 4) = wv; } } while (0)
    { const int tf = dir ? 15 * 128 : 0; S4_LOAD_BC(tf); S4_LOAD_X(0, tf); }
    for (int k = 0; k < 16; ++k) {
        const int c = dir ? 15 - k : k, t0 = c * 128, tn = (dir ? 14 - k : k + 1) * 128;
        __syncthreads();
#pragma unroll
        for (int i = 0; i < 4; ++i) { *(LAS u32x4*)(sBm + (r16 + 32 * i) * TPAD + seg8) = rB[i]; *(LAS u32x4*)(sCm + (r16 + 32 * i) * TPAD + seg8) = rC[i];
            *(LAS u32x4*)(sBmt + (r16 + 32 * i) * TPAD + seg8) = rT[i]; }
        S4_STAGE_X(); S4_STAGE_SB(0);
        if (w < NHU) {
            LAS float* sD = sSc + w * 384;
            const float d0 = dtT[t0 + lane], d1 = dtT[t0 + 64 + lane], a0 = d0 * aneg, a1 = d1 * aneg;
            float s0 = a0, s1 = a1;
#pragma unroll 1
            for (int o = 1; o < 64; o <<= 1) { const float u0 = __shfl_up(s0, o), u1 = __shfl_up(s1, o); if (lane >= o) { s0 += u0; s1 += u1; } }
            const float hh = __shfl(s0, 63); s1 += hh; const float tot = __shfl(s1, 63);
            float c0 = s0, c1 = s1;
            if (dir) { c0 = tot - (s0 - a0); c1 = tot - (s1 - a1); }
            sD[lane] = d0; sD[64 + lane] = d1; sD[128 + lane] = c0; sD[192 + lane] = c1;
            sD[256 + lane] = d0 * __expf(tot - c0); sD[320 + lane] = d1 * __expf(tot - c1);
        }
        if (NHU > 1) S4_LOAD_X(1, t0); else if (k + 1 < 16) S4_LOAD_X(0, tn);
        __syncthreads();
        const int l = 16 * w + fr;
        u32x2 gpk[8];
        { bf16x8 cf[4];
#pragma unroll
        for (int ks = 0; ks < 4; ++ks) cf[ks] = *(const LAS bf16x8*)(sCm + l * TPAD + 32 * ks + fq * 8);
#pragma unroll
        for (int sb = 0; sb < 8; ++sb) {
            const bool need = dir ? (sb >= w) : (sb <= w);
            gpk[sb] = (u32x2){0u, 0u};
            if (need) { f32x4 gacc = (f32x4){0.f, 0.f, 0.f, 0.f};
#pragma unroll
                for (int ks = 0; ks < 4; ++ks) { const bf16x8 bfm = *(const LAS bf16x8*)(sBm + (16 * sb + fr) * TPAD + 32 * ks + fq * 8); gacc = __builtin_amdgcn_mfma_f32_16x16x32_bf16(bfm, cf[ks], gacc, 0, 0, 0); }
                gpk[sb].x = cvt_pk_bf16_c(gacc[0], gacc[1]); gpk[sb].y = cvt_pk_bf16_c(gacc[2], gacc[3]); }
        } }
        __syncthreads();
#pragma unroll
        for (int sb = 0; sb < 8; ++sb) { const bool need = dir ? (sb >= w) : (sb <= w); if (!need) *(LAS u32x2*)(sBm + l * TPAD + 16 * sb + fq * 4) = (u32x2){0u, 0u}; }
#pragma unroll 1
        for (int j = 0; j < NHU; ++j) {
            if (j > 0) {
                __syncthreads();
                S4_STAGE_X(); S4_STAGE_SB(0);
                if (j < NHU - 1) S4_LOAD_X(j + 1, t0); else if (k + 1 < 16) S4_LOAD_X(0, tn);
                __syncthreads();
            }
            const LAS float* sDt = sSc + j * 384; const LAS float* sCs = sDt + 128; const LAS float* sW = sDt + 256;
            const float csl = sCs[l], el = __expf(csl);
            const float dsk = dir ? 0.f : a.in[I_DSKIP][h0 + j];
            asm volatile("" ::: "memory");
#pragma unroll
            for (int sb = 0; sb < 8; ++sb) {
                const bool need = dir ? (sb >= w) : (sb <= w);
                if (need) { const int s0 = 16 * sb + fq * 4; const f32x4 css = *(const LAS f32x4*)(sCs + s0), dts = *(const LAS f32x4*)(sDt + s0);
                    const float gv[4] = {bf_lo(gpk[sb].x), bf_hi(gpk[sb].x), bf_lo(gpk[sb].y), bf_hi(gpk[sb].y)};
                    float mv[4];
#pragma unroll
                    for (int r = 0; r < 4; ++r) { const int sx = s0 + r; const bool ok = dir ? (sx >= l) : (sx <= l); const float e = __expf(fminf(csl - css[r], 0.f)); mv[r] = ok ? gv[r] * e * dts[r] : 0.f; }
                    u32x2 wv; wv.x = cvt_pk_bf16(mv[0], mv[1]); wv.y = cvt_pk_bf16(mv[2], mv[3]);
                    *(LAS u32x2*)(sBm + l * TPAD + s0) = wv; } }
            asm volatile("" ::: "memory");
            const unsigned voY = (unsigned)(l * ldy + fq * 4) * 2u, soY = uY + (unsigned)(t0 * ldy + j * 64) * 2u;
#pragma unroll
            for (int hp = 0; hp < 2; ++hp) {
                f32x4 acc[2];
                acc[0] = (f32x4){0.f, 0.f, 0.f, 0.f}; acc[1] = acc[0];
#pragma unroll
                for (int ks = 0; ks < 4; ++ks) { const bf16x8 cfk = *(const LAS bf16x8*)(sCm + l * TPAD + 32 * ks + fq * 8);
#pragma unroll
                    for (int q = 0; q < 2; ++q) { const bf16x8 sf = *(const LAS bf16x8*)(sSb + (16 * (2 * hp + q) + fr) * TPAD + 32 * ks + fq * 8); acc[q] = __builtin_amdgcn_mfma_f32_16x16x32_bf16(sf, cfk, acc[q], 0, 0, 0); } }
                acc[0] = acc[0] * el; acc[1] = acc[1] * el;
#pragma unroll
                for (int ks = 0; ks < 4; ++ks) { const bf16x8 mfk = *(const LAS bf16x8*)(sBm + l * TPAD + 32 * ks + fq * 8);
#pragma unroll
                    for (int q = 0; q < 2; ++q) { const bf16x8 xf = *(const LAS bf16x8*)(sXt + (16 * (2 * hp + q) + fr) * TPAD + 32 * ks + fq * 8); acc[q] = __builtin_amdgcn_mfma_f32_16x16x32_bf16(xf, mfk, acc[q], 0, 0, 0); } }
#pragma unroll
                for (int q = 0; q < 2; ++q) { const int pb = 2 * hp + q; float yv[4];
#pragma unroll
                    for (int r = 0; r < 4; ++r) yv[r] = acc[q][r] + dsk * bf1(sXt[(16 * pb + fq * 4 + r) * TPAD + l]);
                    u32x2 wv; wv.x = cvt_pk_bf16(yv[0], yv[1]); wv.y = cvt_pk_bf16(yv[2], yv[3]);
                    __builtin_amdgcn_raw_buffer_store_b64(wv, rsW, voY, soY + 32u * pb, 0); }
            }
            const float dec = __expf(dir ? sCs[0] : sCs[127]);
#pragma unroll
            for (int pb = 0; pb < 4; ++pb) accS[0][pb] = accS[0][pb] * dec;
#pragma unroll
            for (int ks = 0; ks < 4; ++ks) { const u32x4 raw = *(const LAS u32x4*)(sBmt + (16 * w + fr) * TPAD + 32 * ks + fq * 8);
                const f32x4 w0 = *(const LAS f32x4*)(sW + 32 * ks + fq * 8), w1 = *(const LAS f32x4*)(sW + 32 * ks + fq * 8 + 4);
                u32x4 o; o.x = cvt_pk_bf16(bf_lo(raw.x) * w0[0], bf_hi(raw.x) * w0[1]); o.y = cvt_pk_bf16(bf_lo(raw.y) * w0[2], bf_hi(raw.y) * w0[3]);
                o.z = cvt_pk_bf16(bf_lo(raw.z) * w1[0], bf_hi(raw.z) * w1[1]); o.w = cvt_pk_bf16(bf_lo(raw.w) * w1[2], bf_hi(raw.w) * w1[3]);
                const bf16x8 btk = __builtin_bit_cast(bf16x8, o);
#pragma unroll
                for (int pb = 0; pb < 4; ++pb) { const bf16x8 xw = *(const LAS bf16x8*)(sXt + (16 * pb + fr) * TPAD + 32 * ks + fq * 8); accS[0][pb] = __builtin_amdgcn_mfma_f32_16x16x32_bf16(btk, xw, accS[0][pb], 0, 0, 0); } }
#pragma unroll
            for (int pb = 0; pb < 4; ++pb) { const f32x4 t0_ = accS[0][pb];
#pragma unroll
                for (int q = 0; q + 1 < NHU; ++q) accS[q][pb] = accS[q + 1][pb];
                accS[NHU - 1][pb] = t0_; }
        }
        if (k + 1 < 16) S4_LOAD_BC(tn);
    }
#undef S4_LOAD_BC
#undef S4_LOAD_X
#undef S4_STAGE_X
#undef S4_STAGE_SB
}

namespace att {
constexpr int SHM_V = 64 * 128 * 2, SHM_K = 64 * 64 * 2;
constexpr int NSLOT = 3;
constexpr int L_V = 0, L_K = NSLOT * SHM_V, L_WS = L_K + NSLOT * SHM_K, L_ST = L_WS + NWAVES * 256, L_END = L_ST + NWAVES * 8192;
static_assert(L_END <= LDS_BYTES - 512, "attn lds");
constexpr float SCALE = 0.125f, THR = 8.f;
#define KSWZ(row, colB) ((row) * 128 + ((colB) ^ (((row) & 7) << 4)))
#define SBAR() __builtin_amdgcn_sched_barrier(0)
__device__ __forceinline__ int crow(int r, int hi) { return (r & 3) + 8 * (r >> 2) + 4 * hi; }
__device__ __forceinline__ void partialSM(f32x16& p0, f32x16& p1, float& m_reg, float& mn, float& alpha) {
    constexpr float C = SCALE * 1.4426950408889634f;
    float pmax = p0[0];
#pragma unroll
    for (int r = 1; r < 16; ++r) pmax = fmaxf(pmax, p0[r]);
#pragma unroll
    for (int r = 0; r < 16; ++r) pmax = fmaxf(pmax, p1[r]);
    { auto rr = __builtin_amdgcn_permlane32_swap(__float_as_uint(pmax), __float_as_uint(pmax), false, false);
      pmax = fmaxf(__uint_as_float(rr[0]), __uint_as_float(rr[1])); }
    if (__builtin_expect(__all(pmax - m_reg <= THR / SCALE), 1)) { mn = m_reg; alpha = 1.f; }
    else { mn = fmaxf(m_reg, pmax); alpha = __builtin_amdgcn_exp2f((m_reg - mn) * C); m_reg = mn; }
    const float mnC = -mn * C;
#pragma unroll
    for (int r = 0; r < 16; ++r) p0[r] = fmaf(p0[r], C, mnC);
#pragma unroll
    for (int r = 0; r < 16; ++r) p1[r] = fmaf(p1[r], C, mnC);
#pragma unroll
    for (int r = 0; r < 16; ++r) p0[r] = __builtin_amdgcn_exp2f(p0[r]);
}
__device__ __forceinline__ float fma_s(float a, float b, float c) { float r; asm("v_fma_f32 %0, %1, %2, %3" : "=v"(r) : "v"(a), "v"(b), "v"(c)); return r; }
__device__ __forceinline__ float add_s(float a, float b) { float r; asm("v_add_f32_e32 %0, %1, %2" : "=v"(r) : "v"(a), "v"(b)); return r; }
__device__ __forceinline__ float max3_s(float a, float b, float c) { float r; asm("v_max3_f32 %0, %1, %2, %3" : "=v"(r) : "v"(a), "v"(b), "v"(c)); return r; }
__device__ __forceinline__ float sm_rowmax(const f32x16& p0, const f32x16& p1) {
    float m0 = max3_s(p0[0], p0[1], p0[2]), m1 = max3_s(p1[0], p1[1], p1[2]);
#pragma unroll
    for (int r = 3; r < 15; r += 2) { m0 = max3_s(m0, p0[r], p0[r + 1]); m1 = max3_s(m1, p1[r], p1[r + 1]); }
    const float pmax = max3_s(m0, m1, fmaxf(p0[15], p1[15]));
    auto rr = __builtin_amdgcn_permlane32_swap(__float_as_uint(pmax), __float_as_uint(pmax), false, false);
    return fmaxf(__uint_as_float(rr[0]), __uint_as_float(rr[1]));
}
__device__ __forceinline__ void sm_scale(f32x16& p0, f32x16& p1, float pmax, float& m_reg, float& mn, float& alpha) {
    constexpr float C = SCALE * 1.4426950408889634f;
    if (__builtin_expect(__all(pmax - m_reg <= THR / SCALE), 1)) { mn = m_reg; alpha = 1.f; }
    else { mn = fmaxf(m_reg, pmax); alpha = __builtin_amdgcn_exp2f((m_reg - mn) * C); m_reg = mn; }
    const float mnC = -mn * C, Cv = C;
#pragma unroll
    for (int r = 0; r < 16; ++r) p0[r] = fma_s(p0[r], Cv, mnC);
#pragma unroll
    for (int r = 0; r < 16; ++r) p1[r] = fma_s(p1[r], Cv, mnC);
}
__device__ __forceinline__ void sm_exp0(f32x16& p0) {
#pragma unroll
    for (int r = 0; r < 16; ++r) p0[r] = __builtin_amdgcn_exp2f(p0[r]);
}
__device__ __forceinline__ void finishSM(f32x16& p0, f32x16& p1, float alpha, float& l_reg, bf16x8& pa0, bf16x8& pa1, bf16x8& pa2, bf16x8& pa3) {
#pragma unroll
    for (int r = 0; r < 16; ++r) p1[r] = __builtin_amdgcn_exp2f(p1[r]);
    float ps = add_s(p0[0], p1[0]), ps2 = add_s(p0[1], p1[1]);
#pragma unroll
    for (int r = 2; r < 16; r += 2) { ps = add_s(ps, p0[r]); ps2 = add_s(ps2, p0[r + 1]); ps = add_s(ps, p1[r]); ps2 = add_s(ps2, p1[r + 1]); }
    ps = add_s(ps, ps2);
    { auto rr = __builtin_amdgcn_permlane32_swap(__float_as_uint(ps), __float_as_uint(ps), false, false);
      ps = __uint_as_float(rr[0]) + __uint_as_float(rr[1]); }
    l_reg = l_reg * alpha + ps;
#define PK4(P, BASE, OUT) do { unsigned a0 = cvt_pk_bf16(P[BASE + 0], P[BASE + 1]), a1 = cvt_pk_bf16(P[BASE + 2], P[BASE + 3]);   \
    unsigned b0 = cvt_pk_bf16(P[BASE + 4], P[BASE + 5]), b1 = cvt_pk_bf16(P[BASE + 6], P[BASE + 7]);                              \
    auto r0 = __builtin_amdgcn_permlane32_swap(a0, b0, false, false); auto r1 = __builtin_amdgcn_permlane32_swap(a1, b1, false, false); \
    u32x4 w_ = {r0[0], r1[0], r0[1], r1[1]}; OUT = *reinterpret_cast<bf16x8*>(&w_); } while (0)
    PK4(p0, 0, pa0); PK4(p0, 8, pa1); PK4(p1, 0, pa2); PK4(p1, 8, pa3);
#undef PK4
}
__device__ __forceinline__ void qkt(f32x16& p0, f32x16& p1, const LAS unsigned char* Ks, const bf16x8* qr, int r32, int hi) {
    p0 = f32x16{}; p1 = f32x16{};
    __builtin_amdgcn_s_setprio(1);
#pragma unroll
    for (int d0 = 0; d0 < 4; ++d0) { const int cb = (d0 * 16 + hi * 8) * 2;
        const bf16x8 b0 = *(const LAS bf16x8*)(Ks + KSWZ(r32, cb));
        const bf16x8 b1 = *(const LAS bf16x8*)(Ks + KSWZ(32 + r32, cb));
        p0 = __builtin_amdgcn_mfma_f32_32x32x16_bf16(b0, qr[d0], p0, 0, 0, 0);
        p1 = __builtin_amdgcn_mfma_f32_32x32x16_bf16(b1, qr[d0], p1, 0, 0, 0); }
    __builtin_amdgcn_s_setprio(0);
}
__device__ __forceinline__ int v_st(int k, int c) { const int kk = (k & ~0xC) | ((k & 4) << 1) | ((k & 8) >> 1); return ((kk >> 3) * 4 + (c >> 5)) * 512 + ((kk & 7) * 32 + (c & 31)) * 2; }
__device__ __forceinline__ int v_rd_base(int lane) { return ((lane & 3) << 3) | (((lane >> 2) & 3) << 6) | (((lane >> 4) & 1) << 5) | (((lane >> 5) & 1) << 8); }
constexpr int v_rd_off(int d0, int ks, int half) { return d0 * 512 + ks * 4096 + half * 2048; }
template <int OFF> __device__ __forceinline__ s16x4 tr_read(int vb) {
    s16x4 r; asm volatile("ds_read_b64_tr_b16 %0, %1 offset:%2" : "=&v"(r) : "v"(vb), "i"(OFF) : "memory"); return r;
}
template <int D0> __device__ __forceinline__ void pv_one(f32x16& od, int vb, bf16x8 pa0, bf16x8 pa1, bf16x8 pa2, bf16x8 pa3) {
    const s16x4 l0 = tr_read<v_rd_off(D0, 0, 0)>(vb), h0 = tr_read<v_rd_off(D0, 0, 1)>(vb), l1 = tr_read<v_rd_off(D0, 1, 0)>(vb), h1 = tr_read<v_rd_off(D0, 1, 1)>(vb);
    const s16x4 l2 = tr_read<v_rd_off(D0, 2, 0)>(vb), h2 = tr_read<v_rd_off(D0, 2, 1)>(vb), l3 = tr_read<v_rd_off(D0, 3, 0)>(vb), h3 = tr_read<v_rd_off(D0, 3, 1)>(vb);
#define PK(L, H) (bf16x8){L[0], L[1], L[2], L[3], H[0], H[1], H[2], H[3]}
    __builtin_amdgcn_s_setprio(1);
    asm volatile("s_waitcnt lgkmcnt(6)" ::: "memory"); SBAR();
    od = __builtin_amdgcn_mfma_f32_32x32x16_bf16(pa0, PK(l0, h0), od, 0, 0, 0); SBAR();
    asm volatile("s_waitcnt lgkmcnt(4)" ::: "memory"); SBAR();
    od = __builtin_amdgcn_mfma_f32_32x32x16_bf16(pa1, PK(l1, h1), od, 0, 0, 0); SBAR();
    asm volatile("s_waitcnt lgkmcnt(2)" ::: "memory"); SBAR();
    od = __builtin_amdgcn_mfma_f32_32x32x16_bf16(pa2, PK(l2, h2), od, 0, 0, 0); SBAR();
    asm volatile("s_waitcnt lgkmcnt(0)" ::: "memory"); SBAR();
    od = __builtin_amdgcn_mfma_f32_32x32x16_bf16(pa3, PK(l3, h3), od, 0, 0, 0);
    __builtin_amdgcn_s_setprio(0);
#undef PK
}
__device__ __forceinline__ void pv_d0(f32x16* o, int vb, bf16x8 pa0, bf16x8 pa1, bf16x8 pa2, bf16x8 pa3) {
    pv_one<0>(o[0], vb, pa0, pa1, pa2, pa3); pv_one<1>(o[1], vb, pa0, pa1, pa2, pa3); pv_one<2>(o[2], vb, pa0, pa1, pa2, pa3); pv_one<3>(o[3], vb, pa0, pa1, pa2, pa3);
}

__device__ __forceinline__ void flash_pass(const bf16_t* __restrict__ Qb, const bf16_t* __restrict__ Kh, const bf16_t* __restrict__ Vh, LAS unsigned char* lds, f32x16 (&o)[4], float (&rli)[16]) {
    const int tid = threadIdx.x, wid = __builtin_amdgcn_readfirstlane(tid >> 6), lane = tid & 63, r32 = lane & 31, hi = lane >> 5;
    LAS unsigned char* V_lds = lds + L_V; LAS unsigned char* K_lds = lds + L_K;
    LAS float* wsp = (LAS float*)(lds + L_WS) + wid * 64; LAS float* li_l = wsp; LAS float* al_l = wsp + 32;
    float m_reg = -1e30f, l_reg = 0;
#pragma unroll
    for (int d = 0; d < 4; ++d) o[d] = f32x16{};
    bf16x8 qr[4];
    const bf16_t* Qw = Qb + (size_t)(wid * 32 + r32) * ULD + hi * 8;
#pragma unroll
    for (int d0 = 0; d0 < 4; ++d0) qr[d0] = *(const bf16x8*)(Qw + d0 * 16);
    const int koff = (wid * 8 + (lane >> 3)) * ULD + (((lane & 7) ^ (lane >> 3)) * 8);
    int voff[2];
#pragma unroll
    for (int i = 0; i < 2; ++i) { const int p = i * 8192 + wid * 1024 + lane * 16, st = p >> 9, q = p & 511, kk = (st >> 2) * 8 + (q >> 6), c = (st & 3) * 32 + ((q & 63) >> 1);
        const int k = (kk & ~0xC) | ((kk & 4) << 1) | ((kk & 8) >> 1); voff[i] = k * ULD + c; }
    const int vb0 = (int)(unsigned)(uintptr_t)V_lds + v_rd_base(lane);
#define ISSUE(t_, slot_) do { const size_t tb_ = (size_t)(t_) * 64 * ULD; \
    __builtin_amdgcn_global_load_lds((const unsigned*)(Kh + tb_ + koff), (LAS unsigned*)(K_lds + (slot_) * SHM_K + wid * 1024), 16, 0, 0); \
    __builtin_amdgcn_global_load_lds((const unsigned*)(Vh + tb_ + voff[0]), (LAS unsigned*)(V_lds + (slot_) * SHM_V + wid * 1024), 16, 0, 0); \
    __builtin_amdgcn_global_load_lds((const unsigned*)(Vh + tb_ + voff[1]), (LAS unsigned*)(V_lds + (slot_) * SHM_V + 8192 + wid * 1024), 16, 0, 0); } while (0)
#define WAITBAR() do { asm volatile("s_waitcnt vmcnt(0)" ::: "memory"); __builtin_amdgcn_s_barrier(); asm volatile("" ::: "memory"); } while (0)
#define RESC(a) do { if (__any((a) < 1.f)) { if (hi == 0) al_l[r32] = (a); asm volatile("s_waitcnt lgkmcnt(0)" ::: "memory"); \
    _Pragma("unroll") for (int d = 0; d < 4; ++d) _Pragma("unroll") for (int r = 0; r < 16; ++r) o[d][r] *= al_l[crow(r, hi)]; } } while (0)
    f32x16 pA0, pA1, pB0, pB1; float mnA, mnB, alA, alB; bf16x8 pa0, pa1, pa2, pa3; constexpr int NT = SEQ / 64;
    ISSUE(0, 0); ISSUE(1, 1);
    WAITBAR();
    qkt(pA0, pA1, K_lds, qr, r32, hi); partialSM(pA0, pA1, m_reg, mnA, alA);
    ISSUE(2, 2);
    int sp = 0, sc = 1;
#define STEP(pX0, pX1, mnX, alX, pY0, pY1, alY, t_) do { \
    SBAR(); qkt(pX0, pX1, K_lds + sc * SHM_K, qr, r32, hi); \
    finishSM(pY0, pY1, alY, l_reg, pa0, pa1, pa2, pa3); SBAR(); \
    { const int vb_ = vb0 + sp * SHM_V; \
      pv_one<0>(o[0], vb_, pa0, pa1, pa2, pa3); const float pm_ = sm_rowmax(pX0, pX1); SBAR(); \
      pv_one<1>(o[1], vb_, pa0, pa1, pa2, pa3); sm_scale(pX0, pX1, pm_, m_reg, mnX, alX); SBAR(); \
      pv_one<2>(o[2], vb_, pa0, pa1, pa2, pa3); sm_exp0(pX0); SBAR(); \
      pv_one<3>(o[3], vb_, pa0, pa1, pa2, pa3); } \
    WAITBAR(); \
    if ((t_) + 2 < NT) ISSUE((t_) + 2, sp); \
    RESC(alX); \
    sp = sc; sc = (sc == NSLOT - 1) ? 0 : sc + 1; } while (0)
    for (int j = 1; j + 1 < NT; j += 2) {
        STEP(pB0, pB1, mnB, alB, pA0, pA1, alA, j);
        STEP(pA0, pA1, mnA, alA, pB0, pB1, alB, j + 1);
    }
    STEP(pB0, pB1, mnB, alB, pA0, pA1, alA, NT - 1);
    finishSM(pB0, pB1, alB, l_reg, pa0, pa1, pa2, pa3); SBAR();
    pv_d0(o, vb0 + sp * SHM_V, pa0, pa1, pa2, pa3);
    if (hi == 0) li_l[r32] = l_reg; asm volatile("s_waitcnt lgkmcnt(0)" ::: "memory");
#pragma unroll
    for (int r = 0; r < 16; ++r) rli[r] = __builtin_amdgcn_rcpf(li_l[crow(r, hi)]);
    __syncthreads();
#undef ISSUE
#undef WAITBAR
#undef RESC
#undef STEP
}

__device__ __forceinline__ void attn_unit(const Args& a, LAS unsigned char* lds, int b, int h, int qb) {
    const int tid = threadIdx.x, wid = tid >> 6, lane = tid & 63, r32 = lane & 31, hi = lane >> 5;
    bf16_t* U = (bf16_t*)(a.ws + WS_BIG);
    const size_t rowq = (size_t)b * SEQ + qb * 256, rowk = (size_t)b * SEQ;
    const float lam = *(const float*)(a.ws + WS_LAM);
    LAS unsigned char* st8 = lds + L_ST + wid * 8192;
    const int segl = r32 >> 3, wi = (r32 & 7) * 2;
    LAS unsigned char* bA[4][2];
#pragma unroll
    for (int k = 0; k < 4; ++k)
#pragma unroll
        for (int j = 0; j < 2; ++j) bA[k][j] = st8 + hi * 1024 + 16 * ((segl ^ k) + 4 * (j ^ hi)) + wi;
#define ST_ADDR(r_, d_) (bA[(r_) & 3][(d_) & 1] + (((r_) & 3) * 256 + ((r_) >> 2) * 2048 + 128 * (((d_) >> 1) ^ (((r_) >> 2) & 1))))
    f32x16 o[4]; float rli[16];
    flash_pass(U + rowq * ULD + h * 128, U + rowk * ULD + 1024 + h * 128, U + rowk * ULD + 2048 + h * 128, lds, o, rli);
#pragma unroll
    for (int r = 0; r < 16; ++r) {
#pragma unroll
        for (int d = 0; d < 4; ++d) *(LAS bf16_t*)ST_ADDR(r, d) = (bf16_t)(cvt_pk_bf16(o[d][r] * rli[r], 0.f) & 0xffffu); }
    flash_pass(U + rowq * ULD + h * 128 + 64, U + rowk * ULD + 1024 + h * 128 + 64, U + rowk * ULD + 2048 + h * 128, lds, o, rli);
    const float* sg = a.in[I_SUBLN];
    float gv[4];
#pragma unroll
    for (int d = 0; d < 4; ++d) gv[d] = sg[32 * d + r32] * 0.8f;
#pragma unroll
    for (int r = 0; r < 16; ++r) {
        float v[4]; float ss = 0.f;
#pragma unroll
        for (int d = 0; d < 4; ++d) { v[d] = bf1(*(const LAS bf16_t*)ST_ADDR(r, d)) - lam * o[d][r] * rli[r]; ss += v[d] * v[d]; }
#pragma unroll
        for (int off = 1; off < 32; off <<= 1) ss += __shfl_xor(ss, off);
        const float q = 1.0f / sqrtf(ss * (1.0f / 128.0f) + EPS);
#pragma unroll
        for (int d = 0; d < 4; ++d) *(LAS bf16_t*)ST_ADDR(r, d) = (bf16_t)(cvt_pk_bf16(v[d] * q * gv[d], 0.f) & 0xffffu);
    }
    asm volatile("s_waitcnt lgkmcnt(0)" ::: "memory");
#pragma unroll
    for (int i = 0; i < 8; ++i) { const int row = i * 4 + (lane >> 4), seg = lane & 15;
        const u32x4 w = *(const LAS u32x4*)(st8 + row * 256 + ((seg ^ (row & 15)) << 4));
        *(u32x4*)(U + (rowq + wid * 32 + row) * ULD + h * 128 + seg * 8) = w; }
#undef ST_ADDR
}
}


#define XB_TMO      128
#define XB_XCNT(j)  (256  + 64 * (j))
#define XB_XSUB(j)  (1280 + 64 * (j))
#define XB_XGEN(j)  (2304 + 64 * (j))
#define XB_TOP      3328
#define XB_TOPGEN   3392
#define XCD_BAR_WORDS 3456
#define XB_SPIN_CAP (1u << 20)
__device__ __forceinline__ unsigned xb_ld(unsigned* p)              { return __hip_atomic_load(p, __ATOMIC_RELAXED, __HIP_MEMORY_SCOPE_AGENT); }
__device__ __forceinline__ unsigned xb_add(unsigned* p, unsigned v) { return __hip_atomic_fetch_add(p, v, __ATOMIC_RELAXED, __HIP_MEMORY_SCOPE_AGENT); }
__device__ __forceinline__ unsigned xb_xcc_id() { return (unsigned)__builtin_amdgcn_s_getreg((3 << 11) | 20) & 0xFu; }
#define XB_SPIN(cond, bar) do { unsigned _sp = 0; while (cond) { __builtin_amdgcn_s_sleep(1); \
    if ((++_sp & 255u) == 0u) { if (xb_ld(&(bar)[XB_TMO])) break; if (_sp > XB_SPIN_CAP) { atomicAdd(&(bar)[XB_TMO], 1u); break; } } } } while (0)
struct XcdBarrier { unsigned* bar; unsigned x; volatile LAS unsigned* st; };
__device__ __forceinline__ XcdBarrier xcd_barrier_post(unsigned* bar, volatile LAS unsigned* st) {
    XcdBarrier b; b.bar = bar; b.x = xb_xcc_id(); b.st = st;
    if (threadIdx.x == 0) (void)xb_add(&bar[XB_XCNT(b.x)], 1u);
    return b;
}
__device__ __forceinline__ void xcd_barrier_complete(unsigned* bar, unsigned x, unsigned& nloc, unsigned& nx) {
    const unsigned G = gridDim.x * gridDim.y * gridDim.z;
    unsigned sum, cnt, mine, sp = 0u;
    for (;;) {
        sum = 0u; cnt = 0u; mine = 0u;
#pragma unroll
        for (unsigned j = 0; j < 16; ++j) { const unsigned c = xb_ld(&bar[XB_XCNT(j)]); sum += c; cnt += (c > 0u) ? 1u : 0u; mine = (j == x) ? c : mine; }
        if (sum == G) break;
        __builtin_amdgcn_s_sleep(1);
        if ((++sp & 255u) == 0u) { if (xb_ld(&bar[XB_TMO])) break; if (sp > XB_SPIN_CAP) { atomicAdd(&bar[XB_TMO], 1u); break; } }
    }
    nloc = mine > 0u ? mine : 1u; nx = cnt > 0u ? cnt : 1u;
}
__device__ __forceinline__ void xcd_barrier(const XcdBarrier& b) {
    asm volatile("s_waitcnt vmcnt(0)" ::: "memory");
    __syncthreads();
    if (threadIdx.x == 0) {
        unsigned* bar = b.bar;
        __builtin_amdgcn_s_waitcnt(0);
        unsigned nloc = b.st[0], nx = b.st[1];
        if (nloc == 0u) { xcd_barrier_complete(bar, b.x, nloc, nx); b.st[0] = nloc; b.st[1] = nx; }
        const unsigned old = xb_add(&bar[XB_XSUB(b.x)], 1u);
        const unsigned gen = old / nloc;
        if (old + 1u == (gen + 1u) * nloc) {
            __builtin_amdgcn_fence(__ATOMIC_RELEASE, "agent");
            asm volatile("s_waitcnt vmcnt(0)" ::: "memory");
            const unsigned og = xb_add(&bar[XB_TOP], 1u);
            const unsigned tg = og / nx;
            if (og + 1u == (tg + 1u) * nx) xb_add(&bar[XB_TOPGEN], 1u);
            else XB_SPIN(xb_ld(&bar[XB_TOPGEN]) == tg, bar);
            __builtin_amdgcn_fence(__ATOMIC_ACQUIRE, "agent");
            xb_add(&bar[XB_XGEN(b.x)], 1u);
            asm volatile("s_waitcnt vmcnt(0)" ::: "memory");
        } else {
            XB_SPIN(xb_ld(&bar[XB_XGEN(b.x)]) == gen, bar);
            __builtin_amdgcn_fence(__ATOMIC_ACQUIRE, "agent");
            asm volatile("s_waitcnt vmcnt(0)" ::: "memory");
        }
    }
    __syncthreads();
}

constexpr int NPHASE = 13;
constexpr int ARG_OFF = LDS_BYTES - 512;
__device__ __forceinline__ const float* argp(LAS unsigned char* lds, int i) {
    const LAS unsigned* p = (const LAS unsigned*)(lds + ARG_OFF) + 2 * i;
    const unsigned lo = __builtin_amdgcn_readfirstlane(p[0]), hi = __builtin_amdgcn_readfirstlane(p[1]);
    return (const float*)(((unsigned long long)hi << 32) | (unsigned long long)lo);
}
#define PH_ARGS(LA) Args LA; LA.out = a.out; LA.ws = a.ws; LA.ph_lo = 0; LA.ph_hi = 0; _Pragma("unroll") for (int i_ = 0; i_ < 29; ++i_) LA.in[i_] = argp(lds, i_);
__global__ void __launch_bounds__(NTHREADS, 2) mk_fwd(Args a) {
    extern __shared__ __attribute__((aligned(16))) unsigned char lds_raw[];
    LAS unsigned char* lds = (LAS unsigned char*)lds_raw;
    const int tid = threadIdx.x;
    const int G = gridDim.x, NGW = G * NWAVES;
#define PH_IDS int tid_ = (int)threadIdx.x; asm volatile("" : "+v"(tid_)); const int lane = tid_ & 63, wave = __builtin_amdgcn_readfirstlane(tid_ >> 6), gw = (int)blockIdx.x * NWAVES + wave;
    unsigned char* ws = a.ws;
    const int lo = a.ph_lo, hi = a.ph_hi;
#ifndef PH_MASK
#define PH_MASK 0x7fff
#endif
#define IN(k) (((PH_MASK >> (k)) & 1) && lo <= (k) && (k) < hi)
#ifndef PH_DUP
#define PH_DUP 0
#endif
#define REP(k) for (int rep_ = 0; rep_ < 1 + ((PH_DUP >> (k)) & 1); ++rep_)
#define SEAM(k) do { if (IN(k) && IN((k) + 1)) { if ((k) == 0) cg::this_grid().sync(); else { XcdBarrier bb_; bb_.bar = (unsigned*)(ws + WS_BAR); bb_.x = xb_xcc_id(); bb_.st = (volatile LAS unsigned*)(lds + ARG_OFF + 256); xcd_barrier(bb_); } } } while (0)
#pragma unroll
    for (int i = 0; i < 29; ++i) if (tid == i) *(LAS unsigned long long*)(lds + ARG_OFF + 8 * i) = (unsigned long long)a.in[i];
    volatile LAS unsigned* bst = (volatile LAS unsigned*)(lds + ARG_OFF + 256);
    if (tid < 2) bst[tid] = 0u;
    __syncthreads();
    if (hi - lo > 1) (void)xcd_barrier_post((unsigned*)(ws + WS_BAR), bst);
    if (IN(0)) REP(0) { PH_IDS; PH_ARGS(la); p0_prologue(la, lds, gw, NGW, wave, lane); __syncthreads(); }
    SEAM(0);
    if (IN(1)) REP(1) { pg8::Gemm g{(const bf16_t*)(ws + WS_XN), (const bf16_t*)(ws + WS_W1), T, 2 * FF, DM, DM}; pg8::StaticOrder S; S.init(T, 2 * FF, G, (int)blockIdx.x);
        pg8::EpiSwiGLU E{(bf16_t*)(ws + WS_BIG)}; pg8::gemm_phase(lds, g, S, E); }
    SEAM(1);
    if (IN(2)) REP(2) { pg8::Gemm g{(const bf16_t*)(ws + WS_BIG), (const bf16_t*)(ws + WS_WD1), T, DM, FF, FF}; pg8::StaticOrder S; S.init(T, DM, G, (int)blockIdx.x);
        pg8::EpiStore E{(bf16_t*)(ws + WS_F), DM}; pg8::gemm_phase(lds, g, S, E); }
    SEAM(2);
    if (IN(3)) REP(3) { PH_IDS; PH_ARGS(la); p3_rows(la, gw, NGW, lane); }
    SEAM(3);
    if (IN(4)) REP(4) { pg8::Gemm g{(const bf16_t*)(ws + WS_XN), (const bf16_t*)(ws + WS_WIN), T, NIN_P, DM, DM}; pg8::StaticOrder S; S.init(T, NIN_P, G, (int)blockIdx.x);
        pg8::EpiUin E{(bf16_t*)(ws + WS_BIG), (float*)(ws + WS_DTT), (const float*)(ws + WS_ROT), argp(lds, I_DTBF), argp(lds, I_DTBB)}; pg8::gemm_phase(lds, g, S, E); }
    SEAM(4);
    if (IN(5)) REP(5) { PH_ARGS(la); p5_conv(la, lds); }
    SEAM(5);
    if (IN(6)) {
        PH_ARGS(la);
        const int vcu = (G % 8 == 0) ? ((int)blockIdx.x % 8) * (G / 8) + (int)blockIdx.x / 8 : (int)blockIdx.x;
        if ((PH_MASK >> 13) & 1) for (int id = vcu; id < NB * 8 * 8; id += G) att::attn_unit(la, lds, id >> 6, (id >> 3) & 7, id & 7);
        __syncthreads();
        if ((PH_MASK >> 14) & 1) REP(6) for (int id = vcu; id < NB * 2 * 2 * (8 / NHU); id += G) ssd_unit4(la, lds, id / (4 * (8 / NHU)), (id / (2 * (8 / NHU))) & 1, (id / (8 / NHU)) & 1, id % (8 / NHU));
        __syncthreads();
    }
    SEAM(6);
    if (IN(7)) REP(7) { PH_IDS; PH_ARGS(la); p7_rows(la, gw, NGW, lane); }
    SEAM(7);
    if (IN(8)) REP(8) { pg8::Gemm g{(const bf16_t*)(ws + WS_BIG), (const bf16_t*)(ws + WS_WOUT), T, DM, 2048, ULD}; pg8::StaticOrder S; S.init(T, DM, G, (int)blockIdx.x);
        pg8::EpiStore E{(bf16_t*)(ws + WS_XN), DM}; pg8::gemm_phase(lds, g, S, E); }
    SEAM(8);
    if (IN(9)) REP(9) { PH_IDS; PH_ARGS(la); p9_rows(la, gw, NGW, lane); }
    SEAM(9);
    if (IN(10)) REP(10) { pg8::Gemm g{(const bf16_t*)(ws + WS_XN3), (const bf16_t*)(ws + WS_W2), T, 2 * FF, DM, DM}; pg8::StaticOrder S; S.init(T, 2 * FF, G, (int)blockIdx.x);
        pg8::EpiSwiGLU E{(bf16_t*)(ws + WS_BIG)}; pg8::gemm_phase(lds, g, S, E); }
    SEAM(10);
    if (IN(11)) REP(11) { pg8::Gemm g{(const bf16_t*)(ws + WS_BIG), (const bf16_t*)(ws + WS_WD2), T, DM, FF, FF}; pg8::StaticOrder S; S.init(T, DM, G, (int)blockIdx.x);
        pg8::EpiStore E{(bf16_t*)(ws + WS_F), DM}; pg8::gemm_phase(lds, g, S, E); }
    SEAM(11);
    if (IN(12)) { PH_IDS; PH_ARGS(la); p12_rows(la, gw, NGW, lane); }
}

extern "C" void kernel_launch(void* const* d_in, const int* in_sizes, int n_in, void* d_out, int out_size, void* d_ws, size_t ws_size, hipStream_t stream) {
    static int grid_blocks = 0;
    if (!grid_blocks) {
        if (n_in != 29 || ws_size < WS_NEED || out_size != T * DM) { fprintf(stderr, "kernel_launch: unexpected shapes n_in %d ws %zu out %d\n", n_in, ws_size, out_size); return; }
        if (hipFuncSetAttribute((const void*)mk_fwd, hipFuncAttributeMaxDynamicSharedMemorySize, LDS_BYTES) != hipSuccess) { fprintf(stderr, "kernel_launch: LDS attribute failed\n"); return; }
        int dev = 0, cus = 0, per_cu = 0;
        hipGetDevice(&dev);
        hipDeviceGetAttribute(&cus, hipDeviceAttributeMultiprocessorCount, dev);
        hipOccupancyMaxActiveBlocksPerMultiprocessor(&per_cu, mk_fwd, NTHREADS, LDS_BYTES);
        if (per_cu < 1) { fprintf(stderr, "kernel_launch: occupancy 0\n"); return; }
        grid_blocks = cus;
    }
    Args a{};
    for (int i = 0; i < 29; ++i) a.in[i] = (const float*)d_in[i];
    a.out = (float*)d_out; a.ws = (unsigned char*)d_ws;
#if MK_SPLIT
    for (int p = 0; p < NPHASE; ++p) { a.ph_lo = p; a.ph_hi = p + 1; hipLaunchKernelGGL(mk_fwd, dim3(grid_blocks), dim3(NTHREADS), LDS_BYTES, stream, a); }
#else
    a.ph_lo = 0; a.ph_hi = NPHASE;
    hipMemsetAsync((unsigned char*)d_ws + WS_BAR, 0, WS_BAR_BYTES, stream);
    void* args[] = {&a};
    hipError_t e = hipLaunchCooperativeKernel((const void*)mk_fwd, dim3(grid_blocks), dim3(NTHREADS), args, LDS_BYTES, stream);
    if (e != hipSuccess) fprintf(stderr, "cooperative launch failed: %s (grid %d)\n", hipGetErrorString(e), grid_blocks);
#endif
}
```

```cpp
#include <hip/hip_runtime.h>
#include <hip/hip_cooperative_groups.h>
#include <cstdio>
#include <cstdint>
namespace cg = cooperative_groups;

#ifndef MK_SPLIT
#define MK_SPLIT 0
#endif

#define LAS __attribute__((address_space(3)))
typedef unsigned short bf16_t;
typedef short bf16x8 __attribute__((ext_vector_type(8)));
typedef short s16x4 __attribute__((ext_vector_type(4)));
typedef float f32x4 __attribute__((ext_vector_type(4)));
typedef float f32x16 __attribute__((ext_vector_type(16)));
typedef unsigned u32x4 __attribute__((ext_vector_type(4)));
typedef unsigned u32x2 __attribute__((ext_vector_type(2)));

constexpr int NB = 32, SEQ = 2048, DM = 1024, FF = 2816, T = NB * SEQ;
constexpr int ULD = 5632;
constexpr int NIN_P = 5888;
constexpr float EPS = 1e-6f;
constexpr int NTHREADS = 512, NWAVES = 8;

constexpr size_t MiB = 1u << 20;
constexpr size_t WS_LAM = 0, WS_ROT = 4096, WS_BAR = 512 * 1024, WS_BAR_BYTES = 16384, WS_DTT = 1 * MiB;
constexpr size_t WS_W1 = 10 * MiB, WS_WD1 = 21 * MiB, WS_WIN = 27 * MiB, WS_WOUT = 39 * MiB, WS_W2 = 43 * MiB, WS_WD2 = 54 * MiB;
constexpr size_t WS_XN = 64 * MiB, WS_F = 192 * MiB, WS_BIG = 320 * MiB, WS_XN3 = 672 * MiB, WS_NEED = 1024 * MiB;
constexpr size_t DO_XT = 0, DO_BM = 128 * MiB, DO_BMT = 160 * MiB, DO_CM = 192 * MiB;

constexpr int LDS_BYTES = 160 * 1024;

__device__ __forceinline__ unsigned cvt_pk_bf16(float lo, float hi) { unsigned r; asm volatile("v_cvt_pk_bf16_f32 %0, %1, %2" : "=v"(r) : "v"(lo), "v"(hi)); return r; }
typedef float f32x2_t __attribute__((ext_vector_type(2)));
typedef __bf16 bf16x2_t __attribute__((ext_vector_type(2)));
__device__ __forceinline__ unsigned cvt_pk_bf16_c(float lo, float hi) { const f32x2_t v = {lo, hi}; const bf16x2_t b = __builtin_convertvector(v, bf16x2_t); return __builtin_bit_cast(unsigned, b); }
__device__ __forceinline__ float bf_lo(unsigned w) { return __uint_as_float(w << 16); }
__device__ __forceinline__ float bf_hi(unsigned w) { return __uint_as_float(w & 0xffff0000u); }
__device__ __forceinline__ float bf1(bf16_t h) { return __uint_as_float(((unsigned)h) << 16); }
__device__ __forceinline__ float wave_sum(float v) {
#pragma unroll
    for (int o = 1; o < 64; o <<= 1) v += __shfl_xor(v, o);
    return v;
}
__device__ __forceinline__ float silu_f(float g) { return g * __builtin_amdgcn_rcpf(1.0f + __builtin_amdgcn_exp2f(-1.4426950408889634f * g)); }

namespace pg8 {
constexpr int BM = 256, BK = 64, HALF = 128, HTB = HALF * BK * 2, STAGE_BYTES = 8 * HTB, NXCD = 8, WGM = 8;
__host__ __device__ __forceinline__ int lds_byte(int r, int c) { const int st = (r >> 4) * 2 + (c >> 5), rr = r & 15, cc = c & 31, ob = rr * 64 + cc * 2; return st * 1024 + (ob ^ (((ob >> 9) & 1) << 5)); }
__host__ __device__ __forceinline__ void stage_rc(int b, int& R, int& C) { const int st = b / 1024, sb = b % 1024, swz = sb ^ (((sb >> 9) & 1) << 5); R = (st >> 1) * 16 + swz / 64; C = (st & 1) * 32 + (swz % 64) / 2; }
__host__ __device__ __forceinline__ int perm32(int rho) { const int n = rho >> 4, i = rho & 15; return 8 * (i >> 2) + 4 * n + (i & 3); }
struct Unit { int pm, pn; };
struct Gemm { const bf16_t* A; const bf16_t* Bt; int M, N, K, lda; };
struct StaticOrder {
    int nM, nN, nwg, G, c;
    __host__ __device__ void init(int M, int N, int G_, int c_) { nM = M / BM; nN = N / BM; nwg = nM * nN; G = G_; c = c_; }
    __host__ __device__ bool next(int i, Unit& u) const {
        const long L = (long)i * G + c; if (L >= nwg) return false;
        int wgid = (int)L; { const int q = nwg / NXCD, r = nwg % NXCD, xcd = wgid % NXCD, off = wgid / NXCD; wgid = (xcd < r ? xcd * (q + 1) : r * (q + 1) + (xcd - r) * q) + off; }
        const int nig = WGM * nN, gid = wgid / nig, fm = gid * WGM, gsz = (nM - fm) < WGM ? (nM - fm) : WGM;
        u.pm = fm + ((wgid % nig) % gsz); u.pn = (wgid % nig) / gsz; return true;
    }
};
template <class Epi>
__device__ __forceinline__ void gemm_phase(LAS unsigned char* lds, const Gemm g, const StaticOrder& S, const Epi& E) {
    const int tid = threadIdx.x, wid = __builtin_amdgcn_readfirstlane(tid >> 6), lane = tid & 63, wr = wid >> 2, wc = wid & 3, fr = lane & 15, fq = lane >> 4;
    const int K = g.K, nt = K / BK, lda = g.lda;
    unsigned voffA[2], voffB[2];
#pragma unroll
    for (int i = 0; i < 2; ++i) { int R, C; stage_rc(tid * 16 + i * 8192, R, C); const int Rb = (R & ~31) + perm32(R & 31); voffA[i] = (unsigned)(R * lda + C) * 2u; voffB[i] = (unsigned)(Rb * K + C) * 2u; }
    const size_t kstep = (size_t)(BK * 2);
    const size_t hstepA = (size_t)HALF * lda * 2, hstepB = (size_t)HALF * K * 2;
    const size_t tstepA = 2 * hstepA, tstepB = 2 * hstepB;
    const unsigned ldsw = (unsigned)wid * 1024u;
    const int aoff = lds_byte(wr * 64 + fr, fq * 8), boff = lds_byte(wc * 32 + fr, fq * 8);
#define PG8_SA(b, h) (((b) * 2 + (h)) * HTB)
#define PG8_SB(b, h) ((4 + (b) * 2 + (h)) * HTB)
#define PG8_STAGE(bufoff, gbase, voff) do { _Pragma("unroll") for (int _i = 0; _i < 2; ++_i) \
        __builtin_amdgcn_global_load_lds((const unsigned*)((const char*)(gbase) + (voff)[_i]), (LAS unsigned*)(lds + (bufoff) + ldsw + _i * 8192), 16, 0, 0); } while (0)
#define PG8_LDA(dst, b, h) do { _Pragma("unroll") for (int m = 0; m < 4; ++m) _Pragma("unroll") for (int k = 0; k < 2; ++k) dst[m][k] = *(const LAS bf16x8*)(lds + PG8_SA(b, h) + aoff + m * 2048 + k * 1024); } while (0)
#define PG8_LDB(dst, b, h) do { _Pragma("unroll") for (int n = 0; n < 2; ++n) _Pragma("unroll") for (int k = 0; k < 2; ++k) dst[n][k] = *(const LAS bf16x8*)(lds + PG8_SB(b, h) + boff + n * 2048 + k * 1024); } while (0)
#define PG8_MMA(ai, bj, At, Bt) do { __builtin_amdgcn_s_setprio(1); _Pragma("unroll") for (int m = 0; m < 4; ++m) _Pragma("unroll") for (int n = 0; n < 2; ++n) _Pragma("unroll") for (int k = 0; k < 2; ++k) \
        acc[ai][bj][m][n] = __builtin_amdgcn_mfma_f32_16x16x32_bf16(Bt[n][k], At[m][k], acc[ai][bj][m][n], 0, 0, 0); __builtin_amdgcn_s_setprio(0); } while (0)
#define PG8_WAIT_V(n) asm volatile("s_waitcnt vmcnt(" #n ")" ::: "memory")
#define PG8_WAIT_L(n) asm volatile("s_waitcnt lgkmcnt(" #n ")" ::: "memory")
#define PG8_BAR __builtin_amdgcn_s_barrier()
#define PG8_SCHED __builtin_amdgcn_sched_barrier(0)
    Unit cur, nxt; int ui = 0;
    if (!S.next(0, cur)) return;
    f32x4 acc[2][2][4][2];
#pragma unroll
    for (int a = 0; a < 2; ++a)
#pragma unroll
        for (int b = 0; b < 2; ++b)
#pragma unroll
            for (int m = 0; m < 4; ++m)
#pragma unroll
                for (int n = 0; n < 2; ++n) acc[a][b][m][n] = (f32x4){0.f, 0.f, 0.f, 0.f};
    bf16x8 At[4][2], B0[2][2], B1[2][2];
    const char* cA = (const char*)g.A + (size_t)cur.pm * tstepA; const char* cB = (const char*)g.Bt + (size_t)cur.pn * tstepB;
    PG8_STAGE(PG8_SB(0, 0), cB, voffB); PG8_STAGE(PG8_SB(0, 1), cB + hstepB, voffB); PG8_STAGE(PG8_SA(0, 0), cA, voffA); PG8_STAGE(PG8_SA(0, 1), cA + hstepA, voffA);
    if (wr == 1) PG8_BAR;
    PG8_WAIT_V(2); PG8_BAR;
    PG8_STAGE(PG8_SB(1, 0), cB + kstep, voffB); PG8_STAGE(PG8_SA(1, 0), cA + kstep, voffA); PG8_STAGE(PG8_SB(1, 1), cB + hstepB + kstep, voffB);
    PG8_WAIT_V(6); PG8_BAR;
    for (;;) {
        const bool has_next = S.next(ui + 1, nxt);
        const char* nA = has_next ? (const char*)g.A + (size_t)nxt.pm * tstepA : cA; const char* nB = has_next ? (const char*)g.Bt + (size_t)nxt.pn * tstepB : cB;
        for (int t = 0; t < nt; t += 2) {
            const bool last = (t == nt - 2);
            const char* a1 = cA + (size_t)(t + 1) * kstep;
            const char* a2 = last ? nA : cA + (size_t)(t + 2) * kstep; const char* b2 = last ? nB : cB + (size_t)(t + 2) * kstep;
            const char* a3 = a2 + kstep; const char* b3 = b2 + kstep;
            PG8_LDB(B0, 0, 0); PG8_LDB(B1, 0, 1); PG8_SCHED; PG8_LDA(At, 0, 0); PG8_STAGE(PG8_SA(1, 1), a1 + hstepA, voffA);
            PG8_WAIT_V(8); PG8_WAIT_L(0); PG8_BAR; PG8_MMA(0, 0, At, B0); PG8_MMA(0, 1, At, B1); PG8_BAR; PG8_SCHED;
            PG8_LDA(At, 0, 1); PG8_STAGE(PG8_SB(0, 0), b2, voffB); PG8_STAGE(PG8_SB(0, 1), b2 + hstepB, voffB); PG8_STAGE(PG8_SA(0, 0), a2, voffA);
            PG8_WAIT_V(8); PG8_WAIT_L(0); PG8_BAR; PG8_MMA(1, 0, At, B0); PG8_MMA(1, 1, At, B1); PG8_BAR; PG8_SCHED;
            PG8_LDB(B0, 1, 0); PG8_LDB(B1, 1, 1); PG8_SCHED; PG8_LDA(At, 1, 0); PG8_STAGE(PG8_SA(0, 1), a2 + hstepA, voffA);
            PG8_WAIT_V(8); PG8_WAIT_L(0); PG8_BAR; PG8_MMA(0, 0, At, B0); PG8_MMA(0, 1, At, B1); PG8_BAR; PG8_SCHED;
            PG8_LDA(At, 1, 1); PG8_STAGE(PG8_SB(1, 0), b3, voffB); PG8_STAGE(PG8_SB(1, 1), b3 + hstepB, voffB); PG8_STAGE(PG8_SA(1, 0), a3, voffA);
            PG8_WAIT_V(8); PG8_WAIT_L(0); PG8_BAR; PG8_MMA(1, 0, At, B0); PG8_MMA(1, 1, At, B1); PG8_BAR; PG8_SCHED;
        }
        if (wr == 0) PG8_BAR;
        E(acc, cur, wr, wc, fr, fq);
        if (!has_next) break;
#pragma unroll
        for (int a = 0; a < 2; ++a)
#pragma unroll
            for (int b = 0; b < 2; ++b)
#pragma unroll
                for (int m = 0; m < 4; ++m)
#pragma unroll
                    for (int n = 0; n < 2; ++n) acc[a][b][m][n] = (f32x4){0.f, 0.f, 0.f, 0.f};
        cur = nxt; cA = nA; cB = nB; ++ui;
        if (wr == 1) PG8_BAR;
    }
    PG8_WAIT_V(0);
    PG8_BAR;
#undef PG8_SA
#undef PG8_SB
#undef PG8_STAGE
#undef PG8_LDA
#undef PG8_LDB
#undef PG8_MMA
#undef PG8_WAIT_V
#undef PG8_WAIT_L
#undef PG8_BAR
#undef PG8_SCHED
}

__device__ __forceinline__ u32x4 pack8(const f32x4& a, const f32x4& b) { u32x4 w; w.x = cvt_pk_bf16_c(a[0], a[1]); w.y = cvt_pk_bf16_c(a[2], a[3]); w.z = cvt_pk_bf16_c(b[0], b[1]); w.w = cvt_pk_bf16_c(b[2], b[3]); return w; }
struct EpiStore {
    bf16_t* O; int ldc;
    __device__ __forceinline__ void operator()(const f32x4 (&acc)[2][2][4][2], const Unit& u, int wr, int wc, int fr, int fq) const {
        const int row0 = u.pm * BM + wr * 64 + fr, col0 = u.pn * BM + wc * 32 + fq * 8;
#pragma unroll
        for (int ai = 0; ai < 2; ++ai)
#pragma unroll
            for (int m = 0; m < 4; ++m) { bf16_t* rp = O + (size_t)(row0 + ai * HALF + m * 16) * ldc + col0;
#pragma unroll
                for (int bj = 0; bj < 2; ++bj) *(u32x4*)(rp + bj * HALF) = pack8(acc[ai][bj][m][0], acc[ai][bj][m][1]); }
    }
};
struct EpiSwiGLU {
    bf16_t* O;
    __device__ __forceinline__ void operator()(const f32x4 (&acc)[2][2][4][2], const Unit& u, int wr, int wc, int fr, int fq) const {
        const int row0 = u.pm * BM + wr * 64 + fr, col0 = u.pn * HALF + wc * 32 + fq * 8;
#pragma unroll
        for (int ai = 0; ai < 2; ++ai)
#pragma unroll
            for (int m = 0; m < 4; ++m) { bf16_t* rp = O + (size_t)(row0 + ai * HALF + m * 16) * FF + col0;
                f32x4 h[2];
#pragma unroll
                for (int n = 0; n < 2; ++n) { const f32x4 gv = acc[ai][0][m][n], uv = acc[ai][1][m][n];
                    h[n] = (f32x4){silu_f(gv[0]) * uv[0], silu_f(gv[1]) * uv[1], silu_f(gv[2]) * uv[2], silu_f(gv[3]) * uv[3]}; }
                *(u32x4*)rp = pack8(h[0], h[1]); }
    }
};
struct EpiUin {
    bf16_t* U; float* dtT; const float* rot; const float* bias_f; const float* bias_b;
    __device__ __forceinline__ void operator()(const f32x4 (&acc)[2][2][4][2], const Unit& u, int wr, int wc, int fr, int fq) const {
        const int row0 = u.pm * BM + wr * 64 + fr;
        if (u.pn == 22) {
            if (wc == 0) {
                const float* bp = (fq < 2) ? (bias_f + fq * 8) : (bias_b + (fq - 2) * 8);
                const f32x4 b0 = *(const f32x4*)bp, b1 = *(const f32x4*)(bp + 4);
                const unsigned vo = (unsigned)(fq * 8) * (unsigned)T + (unsigned)row0;
#pragma unroll
                for (int n = 0; n < 2; ++n)
#pragma unroll
                    for (int e = 0; e < 4; ++e) { float* cb = dtT + (size_t)(n * 4 + e) * T; const float bb = n ? b1[e] : b0[e];
#pragma unroll
                        for (int ai = 0; ai < 2; ++ai)
#pragma unroll
                            for (int m = 0; m < 4; ++m) { const float xv = acc[ai][0][m][n][e] + bb; const float ex = __expf(fminf(xv, 15.f));
                                const float sp = xv > 15.f ? xv : (ex < 0.01f ? ex * (1.f - ex * (0.5f - ex * (1.f / 3.f))) : __logf(1.f + ex));
                                cb[vo + (unsigned)(ai * HALF + m * 16)] = sp; } }
            }
            return;
        }
        const int col0 = u.pn * BM + wc * 32 + fq * 8;
        if (u.pn < 8) {
            const bool rot_ok = ((wc & 1) == 0) && (fq < 2);
#pragma unroll
            for (int ai = 0; ai < 2; ++ai)
#pragma unroll
                for (int m = 0; m < 4; ++m) { const int row = row0 + ai * HALF + m * 16; bf16_t* rp = U + (size_t)row * ULD + col0;
                    const float* rp_ = rot + (size_t)(row & (SEQ - 1)) * 16 + (fq & 1) * 8;
#pragma unroll
                    for (int bj = 0; bj < 2; ++bj) { f32x4 v0 = acc[ai][bj][m][0], v1 = acc[ai][bj][m][1];
                        { f32x4 cs = *(const f32x4*)rp_; if (!rot_ok) cs = (f32x4){1.f, 0.f, 1.f, 0.f};
                          const float a0 = v0[0], a1 = v0[2];
                          v0[0] = a0 * cs[0] - v0[1] * cs[1]; v0[1] = v0[1] * cs[0] + a0 * cs[1]; v0[2] = a1 * cs[2] - v0[3] * cs[3]; v0[3] = v0[3] * cs[2] + a1 * cs[3]; }
                        { f32x4 cs = *(const f32x4*)(rp_ + 4); if (!rot_ok) cs = (f32x4){1.f, 0.f, 1.f, 0.f};
                          const float a0 = v1[0], a1 = v1[2];
                          v1[0] = a0 * cs[0] - v1[1] * cs[1]; v1[1] = v1[1] * cs[0] + a0 * cs[1]; v1[2] = a1 * cs[2] - v1[3] * cs[3]; v1[3] = v1[3] * cs[2] + a1 * cs[3]; }
                        *(u32x4*)(rp + bj * HALF) = pack8(v0, v1); } }
            return;
        }
#pragma unroll
        for (int ai = 0; ai < 2; ++ai)
#pragma unroll
            for (int m = 0; m < 4; ++m) { bf16_t* rp = U + (size_t)(row0 + ai * HALF + m * 16) * ULD + col0;
#pragma unroll
                for (int bj = 0; bj < 2; ++bj) *(u32x4*)(rp + bj * HALF) = pack8(acc[ai][bj][m][0], acc[ai][bj][m][1]); }
    }
};
}

struct Args {
    const float* in[29]; float* out; unsigned char* ws; int ph_lo, ph_hi;
};
enum { I_X = 0, I_F1PRE, I_F1G, I_F1U, I_F1D, I_F1POST, I_MIXPRE, I_WIN, I_LQ1, I_LK1, I_LQ2, I_LK2, I_SUBLN, I_CONVW, I_CONVB, I_ALOGF, I_ALOGB, I_DTBF, I_DTBB,
       I_DSKIP, I_SSDG, I_WOUT, I_MIXPOST, I_F2PRE, I_F2G, I_F2U, I_F2D, I_F2POST, I_FINAL };

__device__ __forceinline__ int dst_row(int mode, int row_off, int n) {
    if (mode == 0) return row_off + n;
    if (mode == 1) return (n >> 7) * 256 + (n & 127) + row_off;
    if (n < 2048) { const int j = n & 63; if (j < 16) return (n & ~63) + ((j < 8) ? 2 * j : 2 * (j - 8) + 1); }
    return n;
}
__device__ __forceinline__ void p0_transpose_item(const float* W, int K, int N, bf16_t* WT, int mode, int row_off, LAS float* scr, int item, int lane) {
    const int nblk = N / 32, kb = item / nblk, nb = item % nblk, k0 = 64 * kb, n0 = 32 * nb;
    { f32x4 t[8];
#pragma unroll
      for (int i = 0; i < 8; ++i) t[i] = *(const f32x4*)(W + (size_t)(k0 + 8 * i + (lane >> 3)) * N + n0 + (lane & 7) * 4);
#pragma unroll
      for (int i = 0; i < 8; ++i) { LAS float* d = scr + (8 * i + (lane >> 3)) * 33 + (lane & 7) * 4; d[0] = t[i][0]; d[1] = t[i][1]; d[2] = t[i][2]; d[3] = t[i][3]; } }
    asm volatile("s_waitcnt lgkmcnt(0)" ::: "memory");
    const int c = lane & 7;
#pragma unroll
    for (int j = 0; j < 4; ++j) { const int n = (lane >> 3) + 8 * j; const LAS float* s = scr + (8 * c) * 33 + n;
        u32x4 o; o.x = cvt_pk_bf16(s[0 * 33], s[1 * 33]); o.y = cvt_pk_bf16(s[2 * 33], s[3 * 33]); o.z = cvt_pk_bf16(s[4 * 33], s[5 * 33]); o.w = cvt_pk_bf16(s[6 * 33], s[7 * 33]);
        *(u32x4*)(WT + (size_t)dst_row(mode, row_off, n0 + n) * K + k0 + 8 * c) = o; }
    asm volatile("s_waitcnt lgkmcnt(0)" ::: "memory");
}

struct Row { f32x4 v[4]; };
__device__ __forceinline__ Row ld_row_f32(const float* p, int lane) { Row r; const f32x4* q = (const f32x4*)p + lane * 2;
#pragma unroll
    for (int j = 0; j < 2; ++j) { r.v[2 * j] = q[128 * j]; r.v[2 * j + 1] = q[128 * j + 1]; } return r; }
__device__ __forceinline__ Row ld_row_bf16(const bf16_t* p, int lane) { Row r; const u32x4* q = (const u32x4*)p + lane;
#pragma unroll
    for (int j = 0; j < 2; ++j) { const u32x4 w = q[64 * j]; r.v[2 * j] = (f32x4){bf_lo(w.x), bf_hi(w.x), bf_lo(w.y), bf_hi(w.y)}; r.v[2 * j + 1] = (f32x4){bf_lo(w.z), bf_hi(w.z), bf_lo(w.w), bf_hi(w.w)}; } return r; }
__device__ __forceinline__ void st_row_f32(float* p, int lane, const Row& r) { f32x4* q = (f32x4*)p + lane * 2;
#pragma unroll
    for (int j = 0; j < 2; ++j) { q[128 * j] = r.v[2 * j]; q[128 * j + 1] = r.v[2 * j + 1]; } }
__device__ __forceinline__ void st_row_bf16(bf16_t* p, int lane, const Row& r) { u32x4* q = (u32x4*)p + lane;
#pragma unroll
    for (int j = 0; j < 2; ++j) { u32x4 w; w.x = cvt_pk_bf16(r.v[2 * j][0], r.v[2 * j][1]); w.y = cvt_pk_bf16(r.v[2 * j][2], r.v[2 * j][3]);
        w.z = cvt_pk_bf16(r.v[2 * j + 1][0], r.v[2 * j + 1][1]); w.w = cvt_pk_bf16(r.v[2 * j + 1][2], r.v[2 * j + 1][3]); q[64 * j] = w; } }
__device__ __forceinline__ float row_ss(const Row& r) { float s = 0.f;
#pragma unroll
    for (int j = 0; j < 4; ++j) s += (r.v[j][0] * r.v[j][0] + r.v[j][1] * r.v[j][1]) + (r.v[j][2] * r.v[j][2] + r.v[j][3] * r.v[j][3]);
    return wave_sum(s); }
__device__ __forceinline__ float rs_of(float ss) { return 1.0f / sqrtf(ss * (1.0f / DM) + EPS); }

__device__ __forceinline__ void p0_prologue(const Args& a, LAS unsigned char* lds, int gw, int NGW, int wave, int lane) {
    unsigned char* ws = a.ws;
    LAS float* scr = (LAS float*)(lds + wave * 16384);
    constexpr int I_GU = (DM / 64) * (FF / 32), I_D = (FF / 64) * (DM / 32), I_IN = (DM / 64) * (5664 / 32), I_OUT = (2048 / 64) * (DM / 32);
    constexpr int NITEMS = 4 * I_GU + 2 * I_D + I_IN + I_OUT;
    for (int it = gw; it < NITEMS; it += NGW) {
        int r = it;
        if (r < I_GU) { p0_transpose_item(a.in[I_F1G], DM, FF, (bf16_t*)(ws + WS_W1), 1, 0, scr, r, lane); continue; } r -= I_GU;
        if (r < I_GU) { p0_transpose_item(a.in[I_F1U], DM, FF, (bf16_t*)(ws + WS_W1), 1, 128, scr, r, lane); continue; } r -= I_GU;
        if (r < I_GU) { p0_transpose_item(a.in[I_F2G], DM, FF, (bf16_t*)(ws + WS_W2), 1, 0, scr, r, lane); continue; } r -= I_GU;
        if (r < I_GU) { p0_transpose_item(a.in[I_F2U], DM, FF, (bf16_t*)(ws + WS_W2), 1, 128, scr, r, lane); continue; } r -= I_GU;
        if (r < I_D) { p0_transpose_item(a.in[I_F1D], FF, DM, (bf16_t*)(ws + WS_WD1), 0, 0, scr, r, lane); continue; } r -= I_D;
        if (r < I_D) { p0_transpose_item(a.in[I_F2D], FF, DM, (bf16_t*)(ws + WS_WD2), 0, 0, scr, r, lane); continue; } r -= I_D;
        if (r < I_IN) { p0_transpose_item(a.in[I_WIN], DM, 5664, (bf16_t*)(ws + WS_WIN), 2, 0, scr, r, lane); continue; } r -= I_IN;
        p0_transpose_item(a.in[I_WOUT], 2048, DM, (bf16_t*)(ws + WS_WOUT), 0, 0, scr, r, lane);
    }
    { u32x4* z = (u32x4*)(ws + WS_WIN + (size_t)5664 * DM * 2); const int n16 = 224 * 2048 / 16;
      for (int i = gw * 64 + lane; i < n16; i += NGW * 64) z[i] = (u32x4){0u, 0u, 0u, 0u}; }
    { float* rot = (float*)(ws + WS_ROT);
      for (int i = gw * 64 + lane; i < SEQ * 8; i += NGW * 64) { const int pos = i >> 3, f = i & 7;
          const float inv = powf(500000.0f, -(float)(2 * f) / 16.0f); const float ang = (float)pos * inv; rot[2 * i] = cosf(ang); rot[2 * i + 1] = sinf(ang); } }
    if (gw == 0) { const float q1 = a.in[I_LQ1][lane] * a.in[I_LK1][lane], q2 = a.in[I_LQ2][lane] * a.in[I_LK2][lane];
        const float s1 = wave_sum(q1), s2 = wave_sum(q2); if (lane == 0) *(float*)(ws + WS_LAM) = expf(s1) - expf(s2) + 0.2f; }
    const Row g = ld_row_f32(a.in[I_F1PRE], lane);
    bf16_t* XN = (bf16_t*)(ws + WS_XN);
    for (int m0 = gw; m0 < T; m0 += 2 * NGW) {
        Row x[2];
#pragma unroll
        for (int u = 0; u < 2; ++u) { const int m = min(m0 + u * NGW, T - 1); x[u] = ld_row_f32(a.in[I_X] + (size_t)m * DM, lane); }
#pragma unroll
        for (int u = 0; u < 2; ++u) { const int m = m0 + u * NGW; const float rs = rs_of(row_ss(x[u]));
#pragma unroll
            for (int j = 0; j < 4; ++j) x[u].v[j] = x[u].v[j] * rs * g.v[j];
            if (m < T) st_row_bf16(XN + (size_t)m * DM, lane, x[u]); }
    }
}

constexpr int RU = 2;
__device__ __forceinline__ void p3_rows(const Args& a, int gw, int NGW, int lane) {
    const Row gp = ld_row_f32(a.in[I_F1POST], lane), gm = ld_row_f32(a.in[I_MIXPRE], lane);
    const bf16_t* F = (const bf16_t*)(a.ws + WS_F); bf16_t* XN = (bf16_t*)(a.ws + WS_XN);
    for (int m0 = gw; m0 < T; m0 += RU * NGW) {
        Row x[RU], f[RU];
#pragma unroll
        for (int u = 0; u < RU; ++u) { const int m = min(m0 + u * NGW, T - 1); x[u] = ld_row_f32(a.in[I_X] + (size_t)m * DM, lane); f[u] = ld_row_bf16(F + (size_t)m * DM, lane); }
#pragma unroll
        for (int u = 0; u < RU; ++u) { const int m = m0 + u * NGW;
            const float rs = 0.5f * rs_of(row_ss(f[u]));
#pragma unroll
            for (int j = 0; j < 4; ++j) x[u].v[j] = x[u].v[j] + f[u].v[j] * rs * gp.v[j];
            if (m < T) st_row_bf16((bf16_t*)F + (size_t)m * DM, lane, x[u]);
            const float r2 = rs_of(row_ss(x[u]));
#pragma unroll
            for (int j = 0; j < 4; ++j) x[u].v[j] = x[u].v[j] * r2 * gm.v[j];
            if (m < T) st_row_bf16(XN + (size_t)m * DM, lane, x[u]); }
    }
}
__device__ __forceinline__ void p7_rows(const Args& a, int gw, int NGW, int lane) {
    const Row g = ld_row_f32(a.in[I_SSDG], lane);
    bf16_t* U = (bf16_t*)(a.ws + WS_BIG); const bf16_t* YB = (const bf16_t*)(a.ws + WS_XN);
    for (int m0 = gw; m0 < T; m0 += RU * NGW) {
        Row yf[RU], yb[RU], z[RU];
#pragma unroll
        for (int u = 0; u < RU; ++u) { const int m = min(m0 + u * NGW, T - 1);
            yf[u] = ld_row_bf16(U + (size_t)m * ULD + 4096, lane); yb[u] = ld_row_bf16(YB + (size_t)m * DM, lane); z[u] = ld_row_bf16(U + (size_t)m * ULD + 3072, lane); }
#pragma unroll
        for (int u = 0; u < RU; ++u) { const int m = m0 + u * NGW;
#pragma unroll
            for (int j = 0; j < 4; ++j)
#pragma unroll
                for (int e = 0; e < 4; ++e) yf[u].v[j][e] = (yf[u].v[j][e] + yb[u].v[j][e]) * silu_f(z[u].v[j][e]);
            const float rs = rs_of(row_ss(yf[u]));
#pragma unroll
            for (int j = 0; j < 4; ++j) yf[u].v[j] = yf[u].v[j] * rs * g.v[j];
            if (m < T) st_row_bf16(U + (size_t)m * ULD + 1024, lane, yf[u]); }
    }
}
__device__ __forceinline__ void p9_rows(const Args& a, int gw, int NGW, int lane) {
    const Row gm = ld_row_f32(a.in[I_MIXPOST], lane), g2 = ld_row_f32(a.in[I_F2PRE], lane);
    const bf16_t* H1 = (const bf16_t*)(a.ws + WS_F); const bf16_t* Mx = (const bf16_t*)(a.ws + WS_XN); bf16_t* XN3 = (bf16_t*)(a.ws + WS_XN3);
    for (int m0 = gw; m0 < T; m0 += RU * NGW) {
        Row x[RU], mm[RU];
#pragma unroll
        for (int u = 0; u < RU; ++u) { const int m = min(m0 + u * NGW, T - 1);
            x[u] = ld_row_bf16(H1 + (size_t)m * DM, lane); mm[u] = ld_row_bf16(Mx + (size_t)m * DM, lane); }
#pragma unroll
        for (int u = 0; u < RU; ++u) { const int m = m0 + u * NGW;
            const float rm = rs_of(row_ss(mm[u]));
#pragma unroll
            for (int j = 0; j < 4; ++j) x[u].v[j] = x[u].v[j] + mm[u].v[j] * rm * gm.v[j];
            if (m < T) st_row_f32(a.out + (size_t)m * DM, lane, x[u]);
            const float r2 = rs_of(row_ss(x[u]));
#pragma unroll
            for (int j = 0; j < 4; ++j) x[u].v[j] = x[u].v[j] * r2 * g2.v[j];
            if (m < T) st_row_bf16(XN3 + (size_t)m * DM, lane, x[u]); }
    }
}
__device__ __forceinline__ void p12_rows(const Args& a, int gw, int NGW, int lane) {
    const Row gp = ld_row_f32(a.in[I_F2POST], lane), gf = ld_row_f32(a.in[I_FINAL], lane);
    const bf16_t* F = (const bf16_t*)(a.ws + WS_F);
    for (int m0 = gw; m0 < T; m0 += RU * NGW) {
        Row x[RU], f[RU];
#pragma unroll
        for (int u = 0; u < RU; ++u) { const int m = min(m0 + u * NGW, T - 1); x[u] = ld_row_f32(a.out + (size_t)m * DM, lane); f[u] = ld_row_bf16(F + (size_t)m * DM, lane); }
#pragma unroll
        for (int u = 0; u < RU; ++u) { const int m = m0 + u * NGW;
            const float rs = 0.5f * rs_of(row_ss(f[u]));
#pragma unroll
            for (int j = 0; j < 4; ++j) x[u].v[j] = x[u].v[j] + f[u].v[j] * rs * gp.v[j];
            const float r2 = rs_of(row_ss(x[u]));
#pragma unroll
            for (int j = 0; j < 4; ++j) x[u].v[j] = x[u].v[j] * r2 * gf.v[j];
            if (m < T) st_row_f32(a.out + (size_t)m * DM, lane, x[u]); }
    }
}

constexpr int TPAD = 136;
__device__ __forceinline__ void p5_conv(const Args& a, LAS unsigned char* lds) {
    const int tid = threadIdx.x, co = tid & 7, tg = tid >> 3;
    const bf16_t* U = (const bf16_t*)(a.ws + WS_BIG);
    bf16_t* XT = (bf16_t*)((unsigned char*)a.out + DO_XT); bf16_t* BM = (bf16_t*)((unsigned char*)a.out + DO_BM);
    bf16_t* BMT = (bf16_t*)((unsigned char*)a.out + DO_BMT); bf16_t* CM = (bf16_t*)((unsigned char*)a.out + DO_CM);
    LAS bf16_t* Tt = (LAS bf16_t*)lds;
    const float* cw = a.in[I_CONVW]; const float* cb = a.in[I_CONVB];
    const int l0 = 2 * tg;
    constexpr int NITEM = NB * 16 * 24;
    u32x4 raw[6];
#define P5_LOAD(item_) do { const int cg_ = (item_) / (NB * 16), bc_ = (item_) % (NB * 16), c_ = bc_ & 15, b_ = bc_ >> 4; \
    const int ch0_ = (cg_ < 16) ? cg_ * 64 : (cg_ < 20 ? 1024 + (cg_ - 16) * 64 : 1280 + (cg_ - 20) * 64); \
    _Pragma("unroll") for (int j = 0; j < 6; ++j) { const int tt = c_ * 128 + l0 + j - 2; raw[j] = (u32x4){0u, 0u, 0u, 0u}; \
        if (tt >= 0 && tt < SEQ) raw[j] = *(const u32x4*)(U + (size_t)(b_ * SEQ + tt) * ULD + 4096 + ch0_ + co * 8); } } while (0)
    int item = blockIdx.x;
    if (item < NITEM) P5_LOAD(item);
    for (; item < NITEM; item += gridDim.x) {
        const int cg = item / (NB * 16), bc = item % (NB * 16), c = bc & 15, b = bc >> 4;
        const int ch0 = (cg < 16) ? cg * 64 : (cg < 20 ? 1024 + (cg - 16) * 64 : 1280 + (cg - 20) * 64);
        const int chn = ch0 + co * 8;
        u32x4 cur[6];
#pragma unroll
        for (int j = 0; j < 6; ++j) cur[j] = raw[j];
        if (item + (int)gridDim.x < NITEM) P5_LOAD(item + (int)gridDim.x);
        float wv[5][8], bv[8];
#pragma unroll
        for (int j = 0; j < 5; ++j) { const f32x4 w0 = *(const f32x4*)(cw + (size_t)j * 1536 + chn), w1 = *(const f32x4*)(cw + (size_t)j * 1536 + chn + 4);
#pragma unroll
            for (int e = 0; e < 4; ++e) { wv[j][e] = w0[e]; wv[j][4 + e] = w1[e]; } }
        { const f32x4 b0 = *(const f32x4*)(cb + chn), b1 = *(const f32x4*)(cb + chn + 4);
#pragma unroll
          for (int e = 0; e < 4; ++e) { bv[e] = b0[e]; bv[4 + e] = b1[e]; } }
        float o0[8], o1[8];
#pragma unroll
        for (int e = 0; e < 8; ++e) { o0[e] = bv[e]; o1[e] = bv[e]; }
#pragma unroll
        for (int j = 0; j < 6; ++j) {
            const u32x4 w = cur[j];
            float xv[8] = {bf_lo(w.x), bf_hi(w.x), bf_lo(w.y), bf_hi(w.y), bf_lo(w.z), bf_hi(w.z), bf_lo(w.w), bf_hi(w.w)};
            if (j < 5) {
#pragma unroll
                for (int e = 0; e < 8; ++e) o0[e] += wv[j][e] * xv[e]; }
            if (j >= 1) {
#pragma unroll
                for (int e = 0; e < 8; ++e) o1[e] += wv[j - 1][e] * xv[e]; }
        }
#pragma unroll
        for (int e = 0; e < 8; ++e) { o0[e] = silu_f(o0[e]); o1[e] = silu_f(o1[e]); }
        u32x4 p0, p1;
        p0.x = cvt_pk_bf16(o0[0], o0[1]); p0.y = cvt_pk_bf16(o0[2], o0[3]); p0.z = cvt_pk_bf16(o0[4], o0[5]); p0.w = cvt_pk_bf16(o0[6], o0[7]);
        p1.x = cvt_pk_bf16(o1[0], o1[1]); p1.y = cvt_pk_bf16(o1[2], o1[3]); p1.z = cvt_pk_bf16(o1[4], o1[5]); p1.w = cvt_pk_bf16(o1[6], o1[7]);
        const int t0 = c * 128;
        if (cg >= 16) {
            const int q = (cg - 16) & 3, g = q >> 1, n0 = (q & 1) * 64 + co * 8;
            bf16_t* D = (cg < 20 ? BM : CM) + ((size_t)(b * 2 + g) * SEQ + t0 + l0) * 128 + n0;
            *(u32x4*)D = p0; *(u32x4*)(D + 128) = p1;
        }
        if (cg < 20) {
            const unsigned pw[4] = {p0.x, p0.y, p0.z, p0.w}, qw[4] = {p1.x, p1.y, p1.z, p1.w};
#pragma unroll
            for (int e = 0; e < 8; ++e) { const unsigned lo = (e & 1) ? (pw[e >> 1] >> 16) : (pw[e >> 1] & 0xffffu), hi = (e & 1) ? (qw[e >> 1] >> 16) : (qw[e >> 1] & 0xffffu);
                *(LAS unsigned*)(Tt + (co * 8 + e) * TPAD + l0) = lo | (hi << 16); }
            __syncthreads();
            bf16_t* D; if (cg < 16) D = XT + ((size_t)(b * 16 + cg) * 64) * SEQ + t0; else { const int q = cg - 16, g = q >> 1; D = BMT + ((size_t)(b * 2 + g) * 128 + (q & 1) * 64) * SEQ + t0; }
#pragma unroll
            for (int i = 0; i < 2; ++i) { const int qq = tid + 512 * i, ch = qq >> 4, seg = qq & 15;
                *(u32x4*)(D + (size_t)ch * SEQ + seg * 8) = *(const LAS u32x4*)(Tt + ch * TPAD + seg * 8); }
            __syncthreads();
        }
    }
#undef P5_LOAD
}

constexpr int SS_XT = 0, SS_BM = 64 * TPAD * 2, SS_BMT = SS_BM + 128 * TPAD * 2, SS_CM = SS_BMT + 128 * TPAD * 2, SS_SB = SS_CM + 128 * TPAD * 2,
              SS_SC = SS_SB + 64 * TPAD * 2, SS_END = SS_SC + 2048;
static_assert(SS_END <= LDS_BYTES - 512, "ssd lds");
__device__ __forceinline__ void ssd_unit(const Args& a, LAS unsigned char* lds, int b, int h, int dir) {
    const int tid = threadIdx.x, w = __builtin_amdgcn_readfirstlane(tid >> 6), lane = tid & 63, fr = lane & 15, fq = lane >> 4;
    LAS bf16_t* sXt = (LAS bf16_t*)(lds + SS_XT); LAS bf16_t* sBm = (LAS bf16_t*)(lds + SS_BM);
    LAS bf16_t* sBmt = (LAS bf16_t*)(lds + SS_BMT); LAS bf16_t* sCm = (LAS bf16_t*)(lds + SS_CM); LAS bf16_t* sSb = (LAS bf16_t*)(lds + SS_SB);
    LAS float* sDt = (LAS float*)(lds + SS_SC); LAS float* sCs = sDt + 128; LAS float* sW = sDt + 256; LAS float* sTot = sDt + 384;
    const int g = h >> 3;
    const bf16_t* XT = (const bf16_t*)((const unsigned char*)a.out + DO_XT) + ((size_t)(b * 16 + h) * 64) * SEQ;
    const bf16_t* BM = (const bf16_t*)((const unsigned char*)a.out + DO_BM) + ((size_t)(b * 2 + g) * SEQ) * 128;
    const bf16_t* BMT = (const bf16_t*)((const unsigned char*)a.out + DO_BMT) + ((size_t)(b * 2 + g) * 128) * SEQ;
    const bf16_t* CM = (const bf16_t*)((const unsigned char*)a.out + DO_CM) + ((size_t)(b * 2 + g) * SEQ) * 128;
    const float* dtT = (const float*)(a.ws + WS_DTT) + (size_t)(dir * 16 + h) * T + (size_t)b * SEQ;
    const float* alp = dir ? a.in[I_ALOGB] : a.in[I_ALOGF]; const float aneg = -expf(alp[h]);
    const float dsk = dir ? 0.f : a.in[I_DSKIP][h];
    bf16_t* Y; int ldy;
    if (dir == 0) { Y = (bf16_t*)(a.ws + WS_BIG) + 4096 + h * 64; ldy = ULD; } else { Y = (bf16_t*)(a.ws + WS_XN) + h * 64; ldy = DM; }
    Y += (size_t)b * SEQ * ldy;
    f32x4 accS[4];
#pragma unroll
    for (int i = 0; i < 4; ++i) accS[i] = (f32x4){0.f, 0.f, 0.f, 0.f};
    const int r16 = tid >> 4, seg8 = (tid & 15) * 8;
    u32x4 rX[2], rB[4], rC[4], rT[4]; float rd0, rd1;
#define SSD_LOAD(t0_) do { \
    _Pragma("unroll") for (int i = 0; i < 2; ++i) rX[i] = *(const u32x4*)(XT + (size_t)(r16 + 32 * i) * SEQ + (t0_) + seg8); \
    _Pragma("unroll") for (int i = 0; i < 4; ++i) { rB[i] = *(const u32x4*)(BM + (size_t)((t0_) + r16 + 32 * i) * 128 + seg8); \
        rC[i] = *(const u32x4*)(CM + (size_t)((t0_) + r16 + 32 * i) * 128 + seg8); rT[i] = *(const u32x4*)(BMT + (size_t)(r16 + 32 * i) * SEQ + (t0_) + seg8); } \
    rd0 = dtT[(t0_) + lane]; rd1 = dtT[(t0_) + 64 + lane]; } while (0)
    SSD_LOAD(dir ? 15 * 128 : 0);
    for (int k = 0; k < 16; ++k) {
        const int c = dir ? 15 - k : k, t0 = c * 128;
        __syncthreads();
#pragma unroll
        for (int pb = 0; pb < 4; ++pb) { u32x2 wv; wv.x = cvt_pk_bf16(accS[pb][0], accS[pb][1]); wv.y = cvt_pk_bf16(accS[pb][2], accS[pb][3]);
            *(LAS u32x2*)(sSb + (16 * pb + fr) * TPAD + 16 * w + fq * 4) = wv; }
#pragma unroll
        for (int i = 0; i < 2; ++i) *(LAS u32x4*)(sXt + (r16 + 32 * i) * TPAD + seg8) = rX[i];
#pragma unroll
        for (int i = 0; i < 4; ++i) { *(LAS u32x4*)(sBm + (r16 + 32 * i) * TPAD + seg8) = rB[i]; *(LAS u32x4*)(sCm + (r16 + 32 * i) * TPAD + seg8) = rC[i];
            *(LAS u32x4*)(sBmt + (r16 + 32 * i) * TPAD + seg8) = rT[i]; }
        if (w == 0) {
            const float d0 = rd0, d1 = rd1;
            const float a0 = d0 * aneg, a1 = d1 * aneg;
            float s0 = a0, s1 = a1;
#pragma unroll
            for (int o = 1; o < 64; o <<= 1) { const float u0 = __shfl_up(s0, o), u1 = __shfl_up(s1, o); if (lane >= o) { s0 += u0; s1 += u1; } }
            const float h0 = __shfl(s0, 63); s1 += h0; const float tot = __shfl(s1, 63);
            float c0 = s0, c1 = s1;
            if (dir) { c0 = tot - (s0 - a0); c1 = tot - (s1 - a1); }
            sDt[lane] = d0; sDt[64 + lane] = d1; sCs[lane] = c0; sCs[64 + lane] = c1;
            sW[lane] = d0 * __expf(tot - c0); sW[64 + lane] = d1 * __expf(tot - c1);
            if (lane == 0) sTot[0] = tot;
        }
        if (k + 1 < 16) { const int tn = (dir ? 14 - k : k + 1) * 128; SSD_LOAD(tn); }
        __syncthreads();
        const int l = 16 * w + fr;
        const float csl = sCs[l];
        bf16x8 cf[4];
#pragma unroll
        for (int ks = 0; ks < 4; ++ks) cf[ks] = *(const LAS bf16x8*)(sCm + l * TPAD + 32 * ks + fq * 8);
        f32x4 yo[4];
#pragma unroll
        for (int pb = 0; pb < 4; ++pb) { f32x4 acc = (f32x4){0.f, 0.f, 0.f, 0.f};
#pragma unroll
            for (int ks = 0; ks < 4; ++ks) { const bf16x8 sf = *(const LAS bf16x8*)(sSb + (16 * pb + fr) * TPAD + 32 * ks + fq * 8); acc = __builtin_amdgcn_mfma_f32_16x16x32_bf16(sf, cf[ks], acc, 0, 0, 0); }
            yo[pb] = acc; }
#pragma unroll
        for (int sb = 0; sb < 8; ++sb) {
            const bool need = dir ? (sb >= w) : (sb <= w);
            u32x2 wv = (u32x2){0u, 0u};
            if (need) { f32x4 gacc = (f32x4){0.f, 0.f, 0.f, 0.f};
#pragma unroll
                for (int ks = 0; ks < 4; ++ks) { const bf16x8 bfm = *(const LAS bf16x8*)(sBm + (16 * sb + fr) * TPAD + 32 * ks + fq * 8); gacc = __builtin_amdgcn_mfma_f32_16x16x32_bf16(bfm, cf[ks], gacc, 0, 0, 0); }
                const int s0 = 16 * sb + fq * 4; const f32x4 css = *(const LAS f32x4*)(sCs + s0), dts = *(const LAS f32x4*)(sDt + s0);
                float mv[4];
#pragma unroll
                for (int r = 0; r < 4; ++r) { const int s = s0 + r; const bool ok = dir ? (s >= l) : (s <= l); const float e = __expf(fminf(csl - css[r], 0.f)); mv[r] = ok ? gacc[r] * e * dts[r] : 0.f; }
                wv.x = cvt_pk_bf16(mv[0], mv[1]); wv.y = cvt_pk_bf16(mv[2], mv[3]); }
            *(LAS u32x2*)(sCm + l * TPAD + 16 * sb + fq * 4) = wv; }
        bf16x8 mf[4];
#pragma unroll
        for (int ks = 0; ks < 4; ++ks) mf[ks] = *(const LAS bf16x8*)(sCm + l * TPAD + 32 * ks + fq * 8);
        const float el = __expf(csl);
        bf16_t* yrow = Y + (size_t)(t0 + l) * ldy;
#pragma unroll
        for (int pb = 0; pb < 4; ++pb) { f32x4 acc = (f32x4){0.f, 0.f, 0.f, 0.f};
#pragma unroll
            for (int ks = 0; ks < 4; ++ks) { const bf16x8 xf = *(const LAS bf16x8*)(sXt + (16 * pb + fr) * TPAD + 32 * ks + fq * 8); acc = __builtin_amdgcn_mfma_f32_16x16x32_bf16(xf, mf[ks], acc, 0, 0, 0); }
            float yv[4];
#pragma unroll
            for (int r = 0; r < 4; ++r) yv[r] = acc[r] + el * yo[pb][r] + dsk * bf1(sXt[(16 * pb + fq * 4 + r) * TPAD + l]);
            u32x2 wv; wv.x = cvt_pk_bf16(yv[0], yv[1]); wv.y = cvt_pk_bf16(yv[2], yv[3]);
            *(u32x2*)(yrow + 16 * pb + fq * 4) = wv; }
        const float dec = __expf(sTot[0]);
        bf16x8 bt[4];
#pragma unroll
        for (int ks = 0; ks < 4; ++ks) { const u32x4 raw = *(const LAS u32x4*)(sBmt + (16 * w + fr) * TPAD + 32 * ks + fq * 8);
            const f32x4 w0 = *(const LAS f32x4*)(sW + 32 * ks + fq * 8), w1 = *(const LAS f32x4*)(sW + 32 * ks + fq * 8 + 4);
            u32x4 o; o.x = cvt_pk_bf16(bf_lo(raw.x) * w0[0], bf_hi(raw.x) * w0[1]); o.y = cvt_pk_bf16(bf_lo(raw.y) * w0[2], bf_hi(raw.y) * w0[3]);
            o.z = cvt_pk_bf16(bf_lo(raw.z) * w1[0], bf_hi(raw.z) * w1[1]); o.w = cvt_pk_bf16(bf_lo(raw.w) * w1[2], bf_hi(raw.w) * w1[3]);
            bt[ks] = __builtin_bit_cast(bf16x8, o); }
#pragma unroll
        for (int pb = 0; pb < 4; ++pb) { f32x4 acc = accS[pb] * dec;
#pragma unroll
            for (int ks = 0; ks < 4; ++ks) { const bf16x8 xw = *(const LAS bf16x8*)(sXt + (16 * pb + fr) * TPAD + 32 * ks + fq * 8); acc = __builtin_amdgcn_mfma_f32_16x16x32_bf16(bt[ks], xw, acc, 0, 0, 0); }
            accS[pb] = acc; }
    }
#undef SSD_LOAD
}

constexpr int S4_SC = SS_SB + 64 * TPAD * 2, S4_END = S4_SC + 4 * 384 * 4;
static_assert(S4_END <= LDS_BYTES - 512, "ssd4 lds");
constexpr int NHU = 4;
__device__ __forceinline__ void ssd_unit4(const Args& a, LAS unsigned char* lds, int b, int g, int dir, int hq) {
    const int tid = threadIdx.x, w = __builtin_amdgcn_readfirstlane(tid >> 6), lane = tid & 63, fr = lane & 15, fq = lane >> 4;
    LAS bf16_t* sXt = (LAS bf16_t*)(lds + SS_XT); LAS bf16_t* sBm = (LAS bf16_t*)(lds + SS_BM);
    LAS bf16_t* sBmt = (LAS bf16_t*)(lds + SS_BMT); LAS bf16_t* sCm = (LAS bf16_t*)(lds + SS_CM); LAS bf16_t* sSb = (LAS bf16_t*)(lds + SS_SB);
    LAS float* sSc = (LAS float*)(lds + S4_SC);
    const int h0 = g * 8 + hq * NHU;
    const bf16_t* XT = (const bf16_t*)((const unsigned char*)a.out + DO_XT) + ((size_t)(b * 16 + h0) * 64) * SEQ;
    const bf16_t* BM = (const bf16_t*)((const unsigned char*)a.out + DO_BM) + ((size_t)(b * 2 + g) * SEQ) * 128;
    const bf16_t* BMT = (const bf16_t*)((const unsigned char*)a.out + DO_BMT) + ((size_t)(b * 2 + g) * 128) * SEQ;
    const bf16_t* CM = (const bf16_t*)((const unsigned char*)a.out + DO_CM) + ((size_t)(b * 2 + g) * SEQ) * 128;
    const float* dtT = (const float*)(a.ws + WS_DTT) + (size_t)(dir * 16 + h0 + (w % NHU)) * T + (size_t)b * SEQ;
    const float* alp = dir ? a.in[I_ALOGB] : a.in[I_ALOGF]; const float aneg = -expf(alp[h0 + (w % NHU)]);
    const int ldy = dir ? DM : ULD;
    const __amdgpu_buffer_rsrc_t rsW = __builtin_amdgcn_make_buffer_rsrc((void*)a.ws, 0, 0x7fffffff, 0x00020000);
    const unsigned uY = dir ? (unsigned)(WS_XN + ((size_t)b * SEQ * DM + h0 * 64) * 2) : (unsigned)(WS_BIG + ((size_t)b * SEQ * ULD + 4096 + h0 * 64) * 2);
    f32x4 accS[NHU][4];
#pragma unroll
    for (int j = 0; j < NHU; ++j)
#pragma unroll
        for (int i = 0; i < 4; ++i) accS[j][i] = (f32x4){0.f, 0.f, 0.f, 0.f};
    const int r16 = tid >> 4, seg8 = (tid & 15) * 8;
    u32x4 rX[2], rB[4], rC[4], rT[4];
    const unsigned ob = (unsigned)(r16 * 128 + seg8) * 2u, obT = (unsigned)(r16 * SEQ + seg8) * 2u;
    const __amdgpu_buffer_rsrc_t rsrc = __builtin_amdgcn_make_buffer_rsrc((void*)a.out, 0, 0x7fffffff, 0x00020000);
    const unsigned uBM = (unsigned)(DO_BM + ((size_t)(b * 2 + g) * SEQ) * 128 * 2), uCM = (unsigned)(DO_CM + ((size_t)(b * 2 + g) * SEQ) * 128 * 2);
    const unsigned uBMT = (unsigned)(DO_BMT + ((size_t)(b * 2 + g) * 128) * SEQ * 2), uXT = (unsigned)(DO_XT + ((size_t)(b * 16 + h0) * 64) * SEQ * 2);
#define S4_LOAD_BC(t0_) do { \
    _Pragma("unroll") for (int i = 0; i < 4; ++i) { rB[i] = __builtin_amdgcn_raw_buffer_load_b128(rsrc, ob, uBM + (unsigned)((t0_) + 32 * i) * 256u, 0); \
        rC[i] = __builtin_amdgcn_raw_buffer_load_b128(rsrc, ob, uCM + (unsigned)((t0_) + 32 * i) * 256u, 0); \
        rT[i] = __builtin_amdgcn_raw_buffer_load_b128(rsrc, obT, uBMT + (unsigned)(32 * i) * (SEQ * 2u) + (unsigned)(t0_) * 2u, 0); } } while (0)
#define S4_LOAD_X(j_, t0_) do { _Pragma("unroll") for (int i = 0; i < 2; ++i) rX[i] = __builtin_amdgcn_raw_buffer_load_b128(rsrc, obT, uXT + (unsigned)((j_) * 64 + 32 * i) * (SEQ * 2u) + (unsigned)(t0_) * 2u, 0); } while (0)
#define S4_STAGE_X() do { _Pragma("unroll") for (int i = 0; i < 2; ++i) *(LAS u32x4*)(sXt + (r16 + 32 * i) * TPAD + seg8) = rX[i]; } while (0)
#define S4_STAGE_SB(j_) do { _Pragma("unroll") for (int pb = 0; pb < 4; ++pb) { u32x2 wv; wv.x = cvt_pk_bf16_c(accS[j_][pb][0], accS[j_][pb][1]); wv.y = cvt_pk_bf16_c(accS[j_][pb][2], accS[j_][pb][3]); \
        *(LAS u32x2*)(sSb + (16 * pb + fr) * TPAD + 16 * w + fq * 4) = wv; } } while (0)
    { const int tf = dir ? 15 * 128 : 0; S4_LOAD_BC(tf); S4_LOAD_X(0, tf); }
    for (int k = 0; k < 16; ++k) {
        const int c = dir ? 15 - k : k, t0 = c * 128, tn = (dir ? 14 - k : k + 1) * 128;
        __syncthreads();
#pragma unroll
        for (int i = 0; i < 4; ++i) { *(LAS u32x4*)(sBm + (r16 + 32 * i) * TPAD + seg8) = rB[i]; *(LAS u32x4*)(sCm + (r16 + 32 * i) * TPAD + seg8) = rC[i];
            *(LAS u32x4*)(sBmt + (r16 + 32 * i) * TPAD + seg8) = rT[i]; }
        S4_STAGE_X(); S4_STAGE_SB(0);
        if (w < NHU) {
            LAS float* sD = sSc + w * 384;
            const float d0 = dtT[t0 + lane], d1 = dtT[t0 + 64 + lane], a0 = d0 * aneg, a1 = d1 * aneg;
            float s0 = a0, s1 = a1;
#pragma unroll 1
            for (int o = 1; o < 64; o <<= 1) { const float u0 = __shfl_up(s0, o), u1 = __shfl_up(s1, o); if (lane >= o) { s0 += u0; s1 += u1; } }
            const float hh = __shfl(s0, 63); s1 += hh; const float tot = __shfl(s1, 63);
            float c0 = s0, c1 = s1;
            if (dir) { c0 = tot - (s0 - a0); c1 = tot - (s1 - a1); }
            sD[lane] = d0; sD[64 + lane] = d1; sD[128 + lane] = c0; sD[192 + lane] = c1;
            sD[256 + lane] = d0 * __expf(tot - c0); sD[320 + lane] = d1 * __expf(tot - c1);
        }
        if (NHU > 1) S4_LOAD_X(1, t0); else if (k + 1 < 16) S4_LOAD_X(0, tn);
        __syncthreads();
        const int l = 16 * w + fr;
        u32x2 gpk[8];
        { bf16x8 cf[4];
#pragma unroll
        for (int ks = 0; ks < 4; ++ks) cf[ks] = *(const LAS bf16x8*)(sCm + l * TPAD + 32 * ks + fq * 8);
#pragma unroll
        for (int sb = 0; sb < 8; ++sb) {
            const bool need = dir ? (sb >= w) : (sb <= w);
            gpk[sb] = (u32x2){0u, 0u};
            if (need) { f32x4 gacc = (f32x4){0.f, 0.f, 0.f, 0.f};
#pragma unroll
                for (int ks = 0; ks < 4; ++ks) { const bf16x8 bfm = *(const LAS bf16x8*)(sBm + (16 * sb + fr) * TPAD + 32 * ks + fq * 8); gacc = __builtin_amdgcn_mfma_f32_16x16x32_bf16(bfm, cf[ks], gacc, 0, 0, 0); }
                gpk[sb].x = cvt_pk_bf16_c(gacc[0], gacc[1]); gpk[sb].y = cvt_pk_bf16_c(gacc[2], gacc[3]); }
        } }
        __syncthreads();
#pragma unroll
        for (int sb = 0; sb < 8; ++sb) { const bool need = dir ? (sb >= w) : (sb <= w); if (!need) *(LAS u32x2*)(sBm + l * TPAD + 16 * sb + fq * 4) = (u32x2){0u, 0u}; }
#pragma unroll 1
        for (int j = 0; j < NHU; ++j) {
            if (j > 0) {
                __syncthreads();
                S4_STAGE_X(); S4_STAGE_SB(0);
                if (j < NHU - 1) S4_LOAD_X(j + 1, t0); else if (k + 1 < 16) S4_LOAD_X(0, tn);
                __syncthreads();
            }
            const LAS float* sDt = sSc + j * 384; const LAS float* sCs = sDt + 128; const LAS float* sW = sDt + 256;
            const float csl = sCs[l], el = __expf(csl);
            const float dsk = dir ? 0.f : a.in[I_DSKIP][h0 + j];
            asm volatile("" ::: "memory");
#pragma unroll
            for (int sb = 0; sb < 8; ++sb) {
                const bool need = dir ? (sb >= w) : (sb <= w);
                if (need) { const int s0 = 16 * sb + fq * 4; const f32x4 css = *(const LAS f32x4*)(sCs + s0), dts = *(const LAS f32x4*)(sDt + s0);
                    const float gv[4] = {bf_lo(gpk[sb].x), bf_hi(gpk[sb].x), bf_lo(gpk[sb].y), bf_hi(gpk[sb].y)};
                    float mv[4];
#pragma unroll
                    for (int r = 0; r < 4; ++r) { const int sx = s0 + r; const bool ok = dir ? (sx >= l) : (sx <= l); const float e = __expf(fminf(csl - css[r], 0.f)); mv[r] = ok ? gv[r] * e * dts[r] : 0.f; }
                    u32x2 wv; wv.x = cvt_pk_bf16(mv[0], mv[1]); wv.y = cvt_pk_bf16(mv[2], mv[3]);
                    *(LAS u32x2*)(sBm + l * TPAD + s0) = wv; } }
            asm volatile("" ::: "memory");
            const unsigned voY = (unsigned)(l * ldy + fq * 4) * 2u, soY = uY + (unsigned)(t0 * ldy + j * 64) * 2u;
#pragma unroll
            for (int hp = 0; hp < 2; ++hp) {
                f32x4 acc[2];
                acc[0] = (f32x4){0.f, 0.f, 0.f, 0.f}; acc[1] = acc[0];
#pragma unroll
                for (int ks = 0; ks < 4; ++ks) { const bf16x8 cfk = *(const LAS bf16x8*)(sCm + l * TPAD + 32 * ks + fq * 8);
#pragma unroll
                    for (int q = 0; q < 2; ++q) { const bf16x8 sf = *(const LAS bf16x8*)(sSb + (16 * (2 * hp + q) + fr) * TPAD + 32 * ks + fq * 8); acc[q] = __builtin_amdgcn_mfma_f32_16x16x32_bf16(sf, cfk, acc[q], 0, 0, 0); } }
                acc[0] = acc[0] * el; acc[1] = acc[1] * el;
#pragma unroll
                for (int ks = 0; ks < 4; ++ks) { const bf16x8 mfk = *(const LAS bf16x8*)(sBm + l * TPAD + 32 * ks + fq * 8);
#pragma unroll
                    for (int q = 0; q < 2; ++q) { const bf16x8 xf = *(const LAS bf16x8*)(sXt + (16 * (2 * hp + q) + fr) * TPAD + 32 * ks + fq * 8); acc[q] = __builtin_amdgcn_mfma_f32_16x16x32_bf16(xf, mfk, acc[q], 0, 0, 0); } }
#pragma unroll
                for (int q = 0; q < 2; ++q) { const int pb = 2 * hp + q; float yv[4];
#pragma unroll
                    for (int r = 0; r < 4; ++r) yv[r] = acc[q][r] + dsk * bf1(sXt[(16 * pb + fq * 4 + r) * TPAD + l]);
                    u32x2 wv; wv.x = cvt_pk_bf16(yv[0], yv[1]); wv.y = cvt_pk_bf16(yv[2], yv[3]);
                    __builtin_amdgcn_raw_buffer_store_b64(wv, rsW, voY, soY + 32u * pb, 0); }
            }
            const float dec = __expf(dir ? sCs[0] : sCs[127]);
#pragma unroll
            for (int pb = 0; pb < 4; ++pb) accS[0][pb] = accS[0][pb] * dec;
#pragma unroll
            for (int ks = 0; ks < 4; ++ks) { const u32x4 raw = *(const LAS u32x4*)(sBmt + (16 * w + fr) * TPAD + 32 * ks + fq * 8);
                const f32x4 w0 = *(const LAS f32x4*)(sW + 32 * ks + fq * 8), w1 = *(const LAS f32x4*)(sW + 32 * ks + fq * 8 + 4);
                u32x4 o; o.x = cvt_pk_bf16(bf_lo(raw.x) * w0[0], bf_hi(raw.x) * w0[1]); o.y = cvt_pk_bf16(bf_lo(raw.y) * w0[2], bf_hi(raw.y) * w0[3]);
                o.z = cvt_pk_bf16(bf_lo(raw.z) * w1[0], bf_hi(raw.z) * w1[1]); o.w = cvt_pk_bf16(bf_lo(raw.w) * w1[2], bf_hi(raw.w) * w1[3]);
                const bf16x8 btk = __builtin_bit_cast(bf16x8, o);
#pragma unroll
                for (int pb = 0; pb < 4; ++pb) { const bf16x8 xw = *(const LAS bf16x8*)(sXt + (16 * pb + fr) * TPAD + 32 * ks + fq * 8); accS[0][pb] = __builtin_amdgcn_mfma_f32_16x16x32_bf16(btk, xw, accS[0][pb], 0, 0, 0); } }
#pragma unroll
            for (int pb = 0; pb < 4; ++pb) { const f32x4 t0_ = accS[0][pb];
#pragma unroll
                for (int q = 0; q + 1 < NHU; ++q) accS[q][pb] = accS[q + 1][pb];
                accS[NHU - 1][pb] = t0_; }
        }
        if (k + 1 < 16) S4_LOAD_BC(tn);
    }
#undef S4_LOAD_BC
#undef S4_LOAD_X
#undef S4_STAGE_X
#undef S4_STAGE_SB
}

namespace att {
constexpr int SHM_V = 64 * 128 * 2, SHM_K = 64 * 64 * 2;
constexpr int NSLOT = 3;
constexpr int L_V = 0, L_K = NSLOT * SHM_V, L_WS = L_K + NSLOT * SHM_K, L_ST = L_WS + NWAVES * 256, L_END = L_ST + NWAVES * 8192;
static_assert(L_END <= LDS_BYTES - 512, "attn lds");
constexpr float SCALE = 0.125f, THR = 8.f;
#define KSWZ(row, colB) ((row) * 128 + ((colB) ^ (((row) & 7) << 4)))
#define SBAR() __builtin_amdgcn_sched_barrier(0)
__device__ __forceinline__ int crow(int r, int hi) { return (r & 3) + 8 * (r >> 2) + 4 * hi; }
__device__ __forceinline__ void partialSM(f32x16& p0, f32x16& p1, float& m_reg, float& mn, float& alpha) {
    constexpr float C = SCALE * 1.4426950408889634f;
    float pmax = p0[0];
#pragma unroll
    for (int r = 1; r < 16; ++r) pmax = fmaxf(pmax, p0[r]);
#pragma unroll
    for (int r = 0; r < 16; ++r) pmax = fmaxf(pmax, p1[r]);
    { auto rr = __builtin_amdgcn_permlane32_swap(__float_as_uint(pmax), __float_as_uint(pmax), false, false);
      pmax = fmaxf(__uint_as_float(rr[0]), __uint_as_float(rr[1])); }
    if (__builtin_expect(__all(pmax - m_reg <= THR / SCALE), 1)) { mn = m_reg; alpha = 1.f; }
    else { mn = fmaxf(m_reg, pmax); alpha = __builtin_amdgcn_exp2f((m_reg - mn) * C); m_reg = mn; }
    const float mnC = -mn * C;
#pragma unroll
    for (int r = 0; r < 16; ++r) p0[r] = fmaf(p0[r], C, mnC);
#pragma unroll
    for (int r = 0; r < 16; ++r) p1[r] = fmaf(p1[r], C, mnC);
#pragma unroll
    for (int r = 0; r < 16; ++r) p0[r] = __builtin_amdgcn_exp2f(p0[r]);
}
__device__ __forceinline__ float fma_s(float a, float b, float c) { float r; asm("v_fma_f32 %0, %1, %2, %3" : "=v"(r) : "v"(a), "v"(b), "v"(c)); return r; }
__device__ __forceinline__ float add_s(float a, float b) { float r; asm("v_add_f32_e32 %0, %1, %2" : "=v"(r) : "v"(a), "v"(b)); return r; }
__device__ __forceinline__ float max3_s(float a, float b, float c) { float r; asm("v_max3_f32 %0, %1, %2, %3" : "=v"(r) : "v"(a), "v"(b), "v"(c)); return r; }
__device__ __forceinline__ float sm_rowmax(const f32x16& p0, const f32x16& p1) {
    float m0 = max3_s(p0[0], p0[1], p0[2]), m1 = max3_s(p1[0], p1[1], p1[2]);
#pragma unroll
    for (int r = 3; r < 15; r += 2) { m0 = max3_s(m0, p0[r], p0[r + 1]); m1 = max3_s(m1, p1[r], p1[r + 1]); }
    const float pmax = max3_s(m0, m1, fmaxf(p0[15], p1[15]));
    auto rr = __builtin_amdgcn_permlane32_swap(__float_as_uint(pmax), __float_as_uint(pmax), false, false);
    return fmaxf(__uint_as_float(rr[0]), __uint_as_float(rr[1]));
}
__device__ __forceinline__ void sm_scale(f32x16& p0, f32x16& p1, float pmax, float& m_reg, float& mn, float& alpha) {
    constexpr float C = SCALE * 1.4426950408889634f;
    if (__builtin_expect(__all(pmax - m_reg <= THR / SCALE), 1)) { mn = m_reg; alpha = 1.f; }
    else { mn = fmaxf(m_reg, pmax); alpha = __builtin_amdgcn_exp2f((m_reg - mn) * C); m_reg = mn; }
    const float mnC = -mn * C, Cv = C;
#pragma unroll
    for (int r = 0; r < 16; ++r) p0[r] = fma_s(p0[r], Cv, mnC);
#pragma unroll
    for (int r = 0; r < 16; ++r) p1[r] = fma_s(p1[r], Cv, mnC);
}
__device__ __forceinline__ void sm_exp0(f32x16& p0) {
#pragma unroll
    for (int r = 0; r < 16; ++r) p0[r] = __builtin_amdgcn_exp2f(p0[r]);
}
__device__ __forceinline__ void finishSM(f32x16& p0, f32x16& p1, float alpha, float& l_reg, bf16x8& pa0, bf16x8& pa1, bf16x8& pa2, bf16x8& pa3) {
#pragma unroll
    for (int r = 0; r < 16; ++r) p1[r] = __builtin_amdgcn_exp2f(p1[r]);
    float ps = add_s(p0[0], p1[0]), ps2 = add_s(p0[1], p1[1]);
#pragma unroll
    for (int r = 2; r < 16; r += 2) { ps = add_s(ps, p0[r]); ps2 = add_s(ps2, p0[r + 1]); ps = add_s(ps, p1[r]); ps2 = add_s(ps2, p1[r + 1]); }
    ps = add_s(ps, ps2);
    { auto rr = __builtin_amdgcn_permlane32_swap(__float_as_uint(ps), __float_as_uint(ps), false, false);
      ps = __uint_as_float(rr[0]) + __uint_as_float(rr[1]); }
    l_reg = l_reg * alpha + ps;
#define PK4(P, BASE, OUT) do { unsigned a0 = cvt_pk_bf16(P[BASE + 0], P[BASE + 1]), a1 = cvt_pk_bf16(P[BASE + 2], P[BASE + 3]);   \
    unsigned b0 = cvt_pk_bf16(P[BASE + 4], P[BASE + 5]), b1 = cvt_pk_bf16(P[BASE + 6], P[BASE + 7]);                              \
    auto r0 = __builtin_amdgcn_permlane32_swap(a0, b0, false, false); auto r1 = __builtin_amdgcn_permlane32_swap(a1, b1, false, false); \
    u32x4 w_ = {r0[0], r1[0], r0[1], r1[1]}; OUT = *reinterpret_cast<bf16x8*>(&w_); } while (0)
    PK4(p0, 0, pa0); PK4(p0, 8, pa1); PK4(p1, 0, pa2); PK4(p1, 8, pa3);
#undef PK4
}
__device__ __forceinline__ void qkt(f32x16& p0, f32x16& p1, const LAS unsigned char* Ks, const bf16x8* qr, int r32, int hi) {
    p0 = f32x16{}; p1 = f32x16{};
    __builtin_amdgcn_s_setprio(1);
#pragma unroll
    for (int d0 = 0; d0 < 4; ++d0) { const int cb = (d0 * 16 + hi * 8) * 2;
        const bf16x8 b0 = *(const LAS bf16x8*)(Ks + KSWZ(r32, cb));
        const bf16x8 b1 = *(const LAS bf16x8*)(Ks + KSWZ(32 + r32, cb));
        p0 = __builtin_amdgcn_mfma_f32_32x32x16_bf16(b0, qr[d0], p0, 0, 0, 0);
        p1 = __builtin_amdgcn_mfma_f32_32x32x16_bf16(b1, qr[d0], p1, 0, 0, 0); }
    __builtin_amdgcn_s_setprio(0);
}
__device__ __forceinline__ int v_st(int k, int c) { const int kk = (k & ~0xC) | ((k & 4) << 1) | ((k & 8) >> 1); return ((kk >> 3) * 4 + (c >> 5)) * 512 + ((kk & 7) * 32 + (c & 31)) * 2; }
__device__ __forceinline__ int v_rd_base(int lane) { return ((lane & 3) << 3) | (((lane >> 2) & 3) << 6) | (((lane >> 4) & 1) << 5) | (((lane >> 5) & 1) << 8); }
constexpr int v_rd_off(int d0, int ks, int half) { return d0 * 512 + ks * 4096 + half * 2048; }
template <int OFF> __device__ __forceinline__ s16x4 tr_read(int vb) {
    s16x4 r; asm volatile("ds_read_b64_tr_b16 %0, %1 offset:%2" : "=&v"(r) : "v"(vb), "i"(OFF) : "memory"); return r;
}
template <int D0> __device__ __forceinline__ void pv_one(f32x16& od, int vb, bf16x8 pa0, bf16x8 pa1, bf16x8 pa2, bf16x8 pa3) {
    const s16x4 l0 = tr_read<v_rd_off(D0, 0, 0)>(vb), h0 = tr_read<v_rd_off(D0, 0, 1)>(vb), l1 = tr_read<v_rd_off(D0, 1, 0)>(vb), h1 = tr_read<v_rd_off(D0, 1, 1)>(vb);
    const s16x4 l2 = tr_read<v_rd_off(D0, 2, 0)>(vb), h2 = tr_read<v_rd_off(D0, 2, 1)>(vb), l3 = tr_read<v_rd_off(D0, 3, 0)>(vb), h3 = tr_read<v_rd_off(D0, 3, 1)>(vb);
#define PK(L, H) (bf16x8){L[0], L[1], L[2], L[3], H[0], H[1], H[2], H[3]}
    __builtin_amdgcn_s_setprio(1);
    asm volatile("s_waitcnt lgkmcnt(6)" ::: "memory"); SBAR();
    od = __builtin_amdgcn_mfma_f32_32x32x16_bf16(pa0, PK(l0, h0), od, 0, 0, 0); SBAR();
    asm volatile("s_waitcnt lgkmcnt(4)" ::: "memory"); SBAR();
    od = __builtin_amdgcn_mfma_f32_32x32x16_bf16(pa1, PK(l1, h1), od, 0, 0, 0); SBAR();
    asm volatile("s_waitcnt lgkmcnt(2)" ::: "memory"); SBAR();
    od = __builtin_amdgcn_mfma_f32_32x32x16_bf16(pa2, PK(l2, h2), od, 0, 0, 0); SBAR();
    asm volatile("s_waitcnt lgkmcnt(0)" ::: "memory"); SBAR();
    od = __builtin_amdgcn_mfma_f32_32x32x16_bf16(pa3, PK(l3, h3), od, 0, 0, 0);
    __builtin_amdgcn_s_setprio(0);
#undef PK
}
__device__ __forceinline__ void pv_d0(f32x16* o, int vb, bf16x8 pa0, bf16x8 pa1, bf16x8 pa2, bf16x8 pa3) {
    pv_one<0>(o[0], vb, pa0, pa1, pa2, pa3); pv_one<1>(o[1], vb, pa0, pa1, pa2, pa3); pv_one<2>(o[2], vb, pa0, pa1, pa2, pa3); pv_one<3>(o[3], vb, pa0, pa1, pa2, pa3);
}

__device__ __forceinline__ void flash_pass(const bf16_t* __restrict__ Qb, const bf16_t* __restrict__ Kh, const bf16_t* __restrict__ Vh, LAS unsigned char* lds, f32x16 (&o)[4], float (&rli)[16]) {
    const int tid = threadIdx.x, wid = __builtin_amdgcn_readfirstlane(tid >> 6), lane = tid & 63, r32 = lane & 31, hi = lane >> 5;
    LAS unsigned char* V_lds = lds + L_V; LAS unsigned char* K_lds = lds + L_K;
    LAS float* wsp = (LAS float*)(lds + L_WS) + wid * 64; LAS float* li_l = wsp; LAS float* al_l = wsp + 32;
    float m_reg = -1e30f, l_reg = 0;
#pragma unroll
    for (int d = 0; d < 4; ++d) o[d] = f32x16{};
    bf16x8 qr[4];
    const bf16_t* Qw = Qb + (size_t)(wid * 32 + r32) * ULD + hi * 8;
#pragma unroll
    for (int d0 = 0; d0 < 4; ++d0) qr[d0] = *(const bf16x8*)(Qw + d0 * 16);
    const int koff = (wid * 8 + (lane >> 3)) * ULD + (((lane & 7) ^ (lane >> 3)) * 8);
    int voff[2];
#pragma unroll
    for (int i = 0; i < 2; ++i) { const int p = i * 8192 + wid * 1024 + lane * 16, st = p >> 9, q = p & 511, kk = (st >> 2) * 8 + (q >> 6), c = (st & 3) * 32 + ((q & 63) >> 1);
        const int k = (kk & ~0xC) | ((kk & 4) << 1) | ((kk & 8) >> 1); voff[i] = k * ULD + c; }
    const int vb0 = (int)(unsigned)(uintptr_t)V_lds + v_rd_base(lane);
#define ISSUE(t_, slot_) do { const size_t tb_ = (size_t)(t_) * 64 * ULD; \
    __builtin_amdgcn_global_load_lds((const unsigned*)(Kh + tb_ + koff), (LAS unsigned*)(K_lds + (slot_) * SHM_K + wid * 1024), 16, 0, 0); \
    __builtin_amdgcn_global_load_lds((const unsigned*)(Vh + tb_ + voff[0]), (LAS unsigned*)(V_lds + (slot_) * SHM_V + wid * 1024), 16, 0, 0); \
    __builtin_amdgcn_global_load_lds((const unsigned*)(Vh + tb_ + voff[1]), (LAS unsigned*)(V_lds + (slot_) * SHM_V + 8192 + wid * 1024), 16, 0, 0); } while (0)
#define WAITBAR() do { asm volatile("s_waitcnt vmcnt(0)" ::: "memory"); __builtin_amdgcn_s_barrier(); asm volatile("" ::: "memory"); } while (0)
#define RESC(a) do { if (__any((a) < 1.f)) { if (hi == 0) al_l[r32] = (a); asm volatile("s_waitcnt lgkmcnt(0)" ::: "memory"); \
    _Pragma("unroll") for (int d = 0; d < 4; ++d) _Pragma("unroll") for (int r = 0; r < 16; ++r) o[d][r] *= al_l[crow(r, hi)]; } } while (0)
    f32x16 pA0, pA1, pB0, pB1; float mnA, mnB, alA, alB; bf16x8 pa0, pa1, pa2, pa3; constexpr int NT = SEQ / 64;
    ISSUE(0, 0); ISSUE(1, 1);
    WAITBAR();
    qkt(pA0, pA1, K_lds, qr, r32, hi); partialSM(pA0, pA1, m_reg, mnA, alA);
    ISSUE(2, 2);
    int sp = 0, sc = 1;
#define STEP(pX0, pX1, mnX, alX, pY0, pY1, alY, t_) do { \
    SBAR(); qkt(pX0, pX1, K_lds + sc * SHM_K, qr, r32, hi); \
    finishSM(pY0, pY1, alY, l_reg, pa0, pa1, pa2, pa3); SBAR(); \
    { const int vb_ = vb0 + sp * SHM_V; \
      pv_one<0>(o[0], vb_, pa0, pa1, pa2, pa3); const float pm_ = sm_rowmax(pX0, pX1); SBAR(); \
      pv_one<1>(o[1], vb_, pa0, pa1, pa2, pa3); sm_scale(pX0, pX1, pm_, m_reg, mnX, alX); SBAR(); \
      pv_one<2>(o[2], vb_, pa0, pa1, pa2, pa3); sm_exp0(pX0); SBAR(); \
      pv_one<3>(o[3], vb_, pa0, pa1, pa2, pa3); } \
    WAITBAR(); \
    if ((t_) + 2 < NT) ISSUE((t_) + 2, sp); \
    RESC(alX); \
    sp = sc; sc = (sc == NSLOT - 1) ? 0 : sc + 1; } while (0)
    for (int j = 1; j + 1 < NT; j += 2) {
        STEP(pB0, pB1, mnB, alB, pA0, pA1, alA, j);
        STEP(pA0, pA1, mnA, alA, pB0, pB1, alB, j + 1);
    }
    STEP(pB0, pB1, mnB, alB, pA0, pA1, alA, NT - 1);
    finishSM(pB0, pB1, alB, l_reg, pa0, pa1, pa2, pa3); SBAR();
    pv_d0(o, vb0 + sp * SHM_V, pa0, pa1, pa2, pa3);
    if (hi == 0) li_l[r32] = l_reg; asm volatile("s_waitcnt lgkmcnt(0)" ::: "memory");
#pragma unroll
    for (int r = 0; r < 16; ++r) rli[r] = __builtin_amdgcn_rcpf(li_l[crow(r, hi)]);
    __syncthreads();
#undef ISSUE
#undef WAITBAR
#undef RESC
#undef STEP
}

__device__ __forceinline__ void attn_unit(const Args& a, LAS unsigned char* lds, int b, int h, int qb) {
    const int tid = threadIdx.x, wid = tid >> 6, lane = tid & 63, r32 = lane & 31, hi = lane >> 5;
    bf16_t* U = (bf16_t*)(a.ws + WS_BIG);
    const size_t rowq = (size_t)b * SEQ + qb * 256, rowk = (size_t)b * SEQ;
    const float lam = *(const float*)(a.ws + WS_LAM);
    LAS unsigned char* st8 = lds + L_ST + wid * 8192;
    const int segl = r32 >> 3, wi = (r32 & 7) * 2;
    LAS unsigned char* bA[4][2];
#pragma unroll
    for (int k = 0; k < 4; ++k)
#pragma unroll
        for (int j = 0; j < 2; ++j) bA[k][j] = st8 + hi * 1024 + 16 * ((segl ^ k) + 4 * (j ^ hi)) + wi;
#define ST_ADDR(r_, d_) (bA[(r_) & 3][(d_) & 1] + (((r_) & 3) * 256 + ((r_) >> 2) * 2048 + 128 * (((d_) >> 1) ^ (((r_) >> 2) & 1))))
    f32x16 o[4]; float rli[16];
    flash_pass(U + rowq * ULD + h * 128, U + rowk * ULD + 1024 + h * 128, U + rowk * ULD + 2048 + h * 128, lds, o, rli);
#pragma unroll
    for (int r = 0; r < 16; ++r) {
#pragma unroll
        for (int d = 0; d < 4; ++d) *(LAS bf16_t*)ST_ADDR(r, d) = (bf16_t)(cvt_pk_bf16(o[d][r] * rli[r], 0.f) & 0xffffu); }
    flash_pass(U + rowq * ULD + h * 128 + 64, U + rowk * ULD + 1024 + h * 128 + 64, U + rowk * ULD + 2048 + h * 128, lds, o, rli);
    const float* sg = a.in[I_SUBLN];
    float gv[4];
#pragma unroll
    for (int d = 0; d < 4; ++d) gv[d] = sg[32 * d + r32] * 0.8f;
#pragma unroll
    for (int r = 0; r < 16; ++r) {
        float v[4]; float ss = 0.f;
#pragma unroll
        for (int d = 0; d < 4; ++d) { v[d] = bf1(*(const LAS bf16_t*)ST_ADDR(r, d)) - lam * o[d][r] * rli[r]; ss += v[d] * v[d]; }
#pragma unroll
        for (int off = 1; off < 32; off <<= 1) ss += __shfl_xor(ss, off);
        const float q = 1.0f / sqrtf(ss * (1.0f / 128.0f) + EPS);
#pragma unroll
        for (int d = 0; d < 4; ++d) *(LAS bf16_t*)ST_ADDR(r, d) = (bf16_t)(cvt_pk_bf16(v[d] * q * gv[d], 0.f) & 0xffffu);
    }
    asm volatile("s_waitcnt lgkmcnt(0)" ::: "memory");
#pragma unroll
    for (int i = 0; i < 8; ++i) { const int row = i * 4 + (lane >> 4), seg = lane & 15;
        const u32x4 w = *(const LAS u32x4*)(st8 + row * 256 + ((seg ^ (row & 15)) << 4));
        *(u32x4*)(U + (rowq + wid * 32 + row) * ULD + h * 128 + seg * 8) = w; }
#undef ST_ADDR
}
}


#define XB_TMO      128
#define XB_XCNT(j)  (256  + 64 * (j))
#define XB_XSUB(j)  (1280 + 64 * (j))
#define XB_XGEN(j)  (2304 + 64 * (j))
#define XB_TOP      3328
#define XB_TOPGEN   3392
#define XCD_BAR_WORDS 3456
#define XB_SPIN_CAP (1u << 20)
__device__ __forceinline__ unsigned xb_ld(unsigned* p)              { return __hip_atomic_load(p, __ATOMIC_RELAXED, __HIP_MEMORY_SCOPE_AGENT); }
__device__ __forceinline__ unsigned xb_add(unsigned* p, unsigned v) { return __hip_atomic_fetch_add(p, v, __ATOMIC_RELAXED, __HIP_MEMORY_SCOPE_AGENT); }
__device__ __forceinline__ unsigned xb_xcc_id() { return (unsigned)__builtin_amdgcn_s_getreg((3 << 11) | 20) & 0xFu; }
#define XB_SPIN(cond, bar) do { unsigned _sp = 0; while (cond) {   \
    if ((++_sp & 255u) == 0u) { if (xb_ld(&(bar)[XB_TMO])) break; if (_sp > XB_SPIN_CAP) { atomicAdd(&(bar)[XB_TMO], 1u); break; } } } } while (0)
struct XcdBarrier { unsigned* bar; unsigned x; volatile LAS unsigned* st; };
__device__ __forceinline__ XcdBarrier xcd_barrier_post(unsigned* bar, volatile LAS unsigned* st) {
    XcdBarrier b; b.bar = bar; b.x = xb_xcc_id(); b.st = st;
    if (threadIdx.x == 0) (void)xb_add(&bar[XB_XCNT(b.x)], 1u);
    return b;
}
__device__ __forceinline__ void xcd_barrier_complete(unsigned* bar, unsigned x, unsigned& nloc, unsigned& nx) {
    const unsigned G = gridDim.x * gridDim.y * gridDim.z;
    unsigned sum, cnt, mine, sp = 0u;
    for (;;) {
        sum = 0u; cnt = 0u; mine = 0u;
#pragma unroll
        for (unsigned j = 0; j < 16; ++j) { const unsigned c = xb_ld(&bar[XB_XCNT(j)]); sum += c; cnt += (c > 0u) ? 1u : 0u; mine = (j == x) ? c : mine; }
        if (sum == G) break;
        __builtin_amdgcn_s_sleep(1);
        if ((++sp & 255u) == 0u) { if (xb_ld(&bar[XB_TMO])) break; if (sp > XB_SPIN_CAP) { atomicAdd(&bar[XB_TMO], 1u); break; } }
    }
    nloc = mine > 0u ? mine : 1u; nx = cnt > 0u ? cnt : 1u;
}
__device__ __forceinline__ void xcd_barrier(const XcdBarrier& b) {
    asm volatile("s_waitcnt vmcnt(0)" ::: "memory");
    __syncthreads();
    if (threadIdx.x == 0) {
        unsigned* bar = b.bar;
        __builtin_amdgcn_s_waitcnt(0);
        unsigned nloc = b.st[0], nx = b.st[1];
        if (nloc == 0u) { xcd_barrier_complete(bar, b.x, nloc, nx); b.st[0] = nloc; b.st[1] = nx; }
        const unsigned old = xb_add(&bar[XB_XSUB(b.x)], 1u);
        const unsigned gen = old / nloc;
        if (old + 1u == (gen + 1u) * nloc) {
            __builtin_amdgcn_fence(__ATOMIC_RELEASE, "agent");
            asm volatile("s_waitcnt vmcnt(0)" ::: "memory");
            const unsigned og = xb_add(&bar[XB_TOP], 1u);
            const unsigned tg = og / nx;
            if (og + 1u == (tg + 1u) * nx) xb_add(&bar[XB_TOPGEN], 1u);
            else XB_SPIN(xb_ld(&bar[XB_TOPGEN]) == tg, bar);
            __builtin_amdgcn_fence(__ATOMIC_ACQUIRE, "agent");
            xb_add(&bar[XB_XGEN(b.x)], 1u);
            asm volatile("s_waitcnt vmcnt(0)" ::: "memory");
        } else {
            XB_SPIN(xb_ld(&bar[XB_XGEN(b.x)]) == gen, bar);
            __builtin_amdgcn_fence(__ATOMIC_ACQUIRE, "agent");
            asm volatile("s_waitcnt vmcnt(0)" ::: "memory");
        }
    }
    __syncthreads();
}

constexpr int NPHASE = 13;
constexpr int ARG_OFF = LDS_BYTES - 512;
__device__ __forceinline__ const float* argp(LAS unsigned char* lds, int i) {
    const LAS unsigned* p = (const LAS unsigned*)(lds + ARG_OFF) + 2 * i;
    const unsigned lo = __builtin_amdgcn_readfirstlane(p[0]), hi = __builtin_amdgcn_readfirstlane(p[1]);
    return (const float*)(((unsigned long long)hi << 32) | (unsigned long long)lo);
}
#define PH_ARGS(LA) Args LA; LA.out = a.out; LA.ws = a.ws; LA.ph_lo = 0; LA.ph_hi = 0; _Pragma("unroll") for (int i_ = 0; i_ < 29; ++i_) LA.in[i_] = argp(lds, i_);
__global__ void __launch_bounds__(NTHREADS, 2) mk_fwd(Args a) {
    extern __shared__ __attribute__((aligned(16))) unsigned char lds_raw[];
    LAS unsigned char* lds = (LAS unsigned char*)lds_raw;
    const int tid = threadIdx.x;
    const int G = gridDim.x, NGW = G * NWAVES;
#define PH_IDS int tid_ = (int)threadIdx.x; asm volatile("" : "+v"(tid_)); const int lane = tid_ & 63, wave = __builtin_amdgcn_readfirstlane(tid_ >> 6), gw = (int)blockIdx.x * NWAVES + wave;
    unsigned char* ws = a.ws;
    const int lo = a.ph_lo, hi = a.ph_hi;
#ifndef PH_MASK
#define PH_MASK 0x7fff
#endif
#define IN(k) (((PH_MASK >> (k)) & 1) && lo <= (k) && (k) < hi)
#ifndef PH_DUP
#define PH_DUP 0
#endif
#define REP(k) for (int rep_ = 0; rep_ < 1 + ((PH_DUP >> (k)) & 1); ++rep_)
#define SEAM(k) do { if (IN(k) && IN((k) + 1)) { if ((k) == 0) cg::this_grid().sync(); else { XcdBarrier bb_; bb_.bar = (unsigned*)(ws + WS_BAR); bb_.x = xb_xcc_id(); bb_.st = (volatile LAS unsigned*)(lds + ARG_OFF + 256); xcd_barrier(bb_); } } } while (0)
#pragma unroll
    for (int i = 0; i < 29; ++i) if (tid == i) *(LAS unsigned long long*)(lds + ARG_OFF + 8 * i) = (unsigned long long)a.in[i];
    volatile LAS unsigned* bst = (volatile LAS unsigned*)(lds + ARG_OFF + 256);
    if (tid < 2) bst[tid] = 0u;
    __syncthreads();
    if (hi - lo > 1) (void)xcd_barrier_post((unsigned*)(ws + WS_BAR), bst);
    if (IN(0)) REP(0) { PH_IDS; PH_ARGS(la); p0_prologue(la, lds, gw, NGW, wave, lane); __syncthreads(); }
    SEAM(0);
    if (IN(1)) REP(1) { pg8::Gemm g{(const bf16_t*)(ws + WS_XN), (const bf16_t*)(ws + WS_W1), T, 2 * FF, DM, DM}; pg8::StaticOrder S; S.init(T, 2 * FF, G, (int)blockIdx.x);
        pg8::EpiSwiGLU E{(bf16_t*)(ws + WS_BIG)}; pg8::gemm_phase(lds, g, S, E); }
    SEAM(1);
    if (IN(2)) REP(2) { pg8::Gemm g{(const bf16_t*)(ws + WS_BIG), (const bf16_t*)(ws + WS_WD1), T, DM, FF, FF}; pg8::StaticOrder S; S.init(T, DM, G, (int)blockIdx.x);
        pg8::EpiStore E{(bf16_t*)(ws + WS_F), DM}; pg8::gemm_phase(lds, g, S, E); }
    SEAM(2);
    if (IN(3)) REP(3) { PH_IDS; PH_ARGS(la); p3_rows(la, gw, NGW, lane); }
    SEAM(3);
    if (IN(4)) REP(4) { pg8::Gemm g{(const bf16_t*)(ws + WS_XN), (const bf16_t*)(ws + WS_WIN), T, NIN_P, DM, DM}; pg8::StaticOrder S; S.init(T, NIN_P, G, (int)blockIdx.x);
        pg8::EpiUin E{(bf16_t*)(ws + WS_BIG), (float*)(ws + WS_DTT), (const float*)(ws + WS_ROT), argp(lds, I_DTBF), argp(lds, I_DTBB)}; pg8::gemm_phase(lds, g, S, E); }
    SEAM(4);
    if (IN(5)) REP(5) { PH_ARGS(la); p5_conv(la, lds); }
    SEAM(5);
    if (IN(6)) {
        PH_ARGS(la);
        const int vcu = (G % 8 == 0) ? ((int)blockIdx.x % 8) * (G / 8) + (int)blockIdx.x / 8 : (int)blockIdx.x;
        if ((PH_MASK >> 13) & 1) for (int id = vcu; id < NB * 8 * 8; id += G) att::attn_unit(la, lds, id >> 6, (id >> 3) & 7, id & 7);
        __syncthreads();
        if ((PH_MASK >> 14) & 1) REP(6) for (int id = vcu; id < NB * 2 * 2 * (8 / NHU); id += G) ssd_unit4(la, lds, id / (4 * (8 / NHU)), (id / (2 * (8 / NHU))) & 1, (id / (8 / NHU)) & 1, id % (8 / NHU));
        __syncthreads();
    }
    SEAM(6);
    if (IN(7)) REP(7) { PH_IDS; PH_ARGS(la); p7_rows(la, gw, NGW, lane); }
    SEAM(7);
    if (IN(8)) REP(8) { pg8::Gemm g{(const bf16_t*)(ws + WS_BIG), (const bf16_t*)(ws + WS_WOUT), T, DM, 2048, ULD}; pg8::StaticOrder S; S.init(T, DM, G, (int)blockIdx.x);
        pg8::EpiStore E{(bf16_t*)(ws + WS_XN), DM}; pg8::gemm_phase(lds, g, S, E); }
    SEAM(8);
    if (IN(9)) REP(9) { PH_IDS; PH_ARGS(la); p9_rows(la, gw, NGW, lane); }
    SEAM(9);
    if (IN(10)) REP(10) { pg8::Gemm g{(const bf16_t*)(ws + WS_XN3), (const bf16_t*)(ws + WS_W2), T, 2 * FF, DM, DM}; pg8::StaticOrder S; S.init(T, 2 * FF, G, (int)blockIdx.x);
        pg8::EpiSwiGLU E{(bf16_t*)(ws + WS_BIG)}; pg8::gemm_phase(lds, g, S, E); }
    SEAM(10);
    if (IN(11)) REP(11) { pg8::Gemm g{(const bf16_t*)(ws + WS_BIG), (const bf16_t*)(ws + WS_WD2), T, DM, FF, FF}; pg8::StaticOrder S; S.init(T, DM, G, (int)blockIdx.x);
        pg8::EpiStore E{(bf16_t*)(ws + WS_F), DM}; pg8::gemm_phase(lds, g, S, E); }
    SEAM(11);
    if (IN(12)) { PH_IDS; PH_ARGS(la); p12_rows(la, gw, NGW, lane); }
}

extern "C" void kernel_launch(void* const* d_in, const int* in_sizes, int n_in, void* d_out, int out_size, void* d_ws, size_t ws_size, hipStream_t stream) {
    static int grid_blocks = 0;
    if (!grid_blocks) {
        if (n_in != 29 || ws_size < WS_NEED || out_size != T * DM) { fprintf(stderr, "kernel_launch: unexpected shapes n_in %d ws %zu out %d\n", n_in, ws_size, out_size); return; }
        if (hipFuncSetAttribute((const void*)mk_fwd, hipFuncAttributeMaxDynamicSharedMemorySize, LDS_BYTES) != hipSuccess) { fprintf(stderr, "kernel_launch: LDS attribute failed\n"); return; }
        int dev = 0, cus = 0, per_cu = 0;
        hipGetDevice(&dev);
        hipDeviceGetAttribute(&cus, hipDeviceAttributeMultiprocessorCount, dev);
        hipOccupancyMaxActiveBlocksPerMultiprocessor(&per_cu, mk_fwd, NTHREADS, LDS_BYTES);
        if (per_cu < 1) { fprintf(stderr, "kernel_launch: occupancy 0\n"); return; }
        grid_blocks = cus;
    }
    Args a{};
    for (int i = 0; i < 29; ++i) a.in[i] = (const float*)d_in[i];
    a.out = (float*)d_out; a.ws = (unsigned char*)d_ws;
#if MK_SPLIT
    for (int p = 0; p < NPHASE; ++p) { a.ph_lo = p; a.ph_hi = p + 1; hipLaunchKernelGGL(mk_fwd, dim3(grid_blocks), dim3(NTHREADS), LDS_BYTES, stream, a); }
#else
    a.ph_lo = 0; a.ph_hi = NPHASE;
    hipMemsetAsync((unsigned char*)d_ws + WS_BAR, 0, WS_BAR_BYTES, stream);
    void* args[] = {&a};
    hipError_t e = hipLaunchCooperativeKernel((const void*)mk_fwd, dim3(grid_blocks), dim3(NTHREADS), args, LDS_BYTES, stream);
    if (e != hipSuccess) fprintf(stderr, "cooperative launch failed: %s (grid %d)\n", hipGetErrorString(e), grid_blocks);
#endif
}
```
